# Optimizing an MI355X kernel written in HIP

```python
import jax, jax.numpy as jnp
from jax import lax
import numpy as np

D_MODEL = 1024
BATCH = 2
SEQ = 8192
DEPTH = 4

GRID_W = 64
CTX_LEN = 256
N_MIXERS = 3
ROPE_THETA = 10000.0
NORM_EPS = 1e-6
Q_BLOCK = 128

GQA_HEAD_DIM = 128
GQA_Q_HEADS = D_MODEL // 64
GQA_KV_HEADS = GQA_Q_HEADS // 2
GQA_GROUP = GQA_Q_HEADS // GQA_KV_HEADS

HGRN_DK = 128
HGRN_DV = 128
HGRN_HEADS = D_MODEL // HGRN_DK
HGRN_WIDTH = HGRN_HEADS * HGRN_DK
HGRN_CHUNK = 64

MLA_HEADS = D_MODEL // 64
MLA_NOPE = 64
MLA_ROPE = 32
MLA_V = 64
MLA_Q_LORA = 3 * D_MODEL // 4
MLA_KV_LORA = D_MODEL // 4

D_FF = 3 * D_MODEL
CONV_W = 3

N_GQA = (DEPTH + 2) // 3
N_HGRN = (DEPTH + 1) // 3
N_MLA = DEPTH // 3

kernel_name = 'hybrid_gqa_hgrn2_mla_convffn_prefix_dit'


def rms_norm(x, gain):
    x32 = x.astype(jnp.float32)
    y = x32 * lax.rsqrt(jnp.mean(x32 * x32, axis=-1, keepdims=True) + NORM_EPS)
    return (y * gain.astype(jnp.float32)).astype(x.dtype)


def modulate(x, shift, scale):
    return x * (1.0 + scale) + shift


def axial_rope_tables(rows, rot_dim):
    row = jnp.repeat(jnp.arange(rows, dtype=jnp.float32), GRID_W)
    col = jnp.tile(jnp.arange(GRID_W, dtype=jnp.float32), rows)
    axis_dim = rot_dim // 2
    inv_freq = jnp.power(ROPE_THETA, -jnp.arange(0, axis_dim, 2, dtype=jnp.float32) / axis_dim)
    ang = jnp.concatenate([row[:, None] * inv_freq, col[:, None] * inv_freq], axis=-1)
    return jnp.cos(ang), jnp.sin(ang)


def apply_rope(x, cos, sin):
    half = x.shape[-1] // 2
    x32 = x.astype(jnp.float32)
    x1, x2 = x32[..., :half], x32[..., half:]
    return jnp.concatenate([x1 * cos - x2 * sin, x1 * sin + x2 * cos], axis=-1).astype(x.dtype)


def block_attention(q, k, v, scale):
    B, Nq, Hk, G, Dk = q.shape
    nb = Nq // Q_BLOCK
    qb = q.reshape(B, nb, Q_BLOCK, Hk, G, Dk).swapaxes(0, 1)

    def one_block(q_blk):
        s = jnp.einsum('bqhgd,bkhd->bhgqk', q_blk, k).astype(jnp.float32) * scale
        p = jax.nn.softmax(s, axis=-1).astype(v.dtype)
        return jnp.einsum('bhgqk,bkhd->bqhgd', p, v)

    o = lax.map(one_block, qb)
    return o.swapaxes(0, 1).reshape(B, Nq, Hk, G, v.shape[-1])


def dwconv_centered(u, w, b):
    L = u.shape[1]
    pad = CONV_W // 2
    up = jnp.pad(u, ((0, 0), (pad, CONV_W - 1 - pad), (0, 0)))
    out = b
    for j in range(CONV_W):
        out = out + up[:, j:j + L] * w[j]
    return out


def conv_ffn(h, w_in, w_conv, b_conv, w_out):
    u = dwconv_centered(h @ w_in, w_conv, b_conv)
    a, val = jnp.split(u, 2, axis=-1)
    return (jax.nn.silu(a) * val) @ w_out


def gqa_mixer(h, hc, w_in, q_gain, k_gain, w_out, cos, sin, ctx_out):
    qd = GQA_Q_HEADS * GQA_HEAD_DIM
    kd = GQA_KV_HEADS * GQA_HEAD_DIM

    def project(t, rotate):
        B, L, _ = t.shape
        p = t @ w_in
        q = rms_norm(p[..., :qd].reshape(B, L, GQA_Q_HEADS, GQA_HEAD_DIM), q_gain)
        k = rms_norm(p[..., qd:qd + kd].reshape(B, L, GQA_KV_HEADS, GQA_HEAD_DIM), k_gain)
        v = p[..., qd + kd:].reshape(B, L, GQA_KV_HEADS, GQA_HEAD_DIM)
        if rotate:
            q = apply_rope(q, cos[:, None, :], sin[:, None, :])
            k = apply_rope(k, cos[:, None, :], sin[:, None, :])
        return q.reshape(B, L, GQA_KV_HEADS, GQA_GROUP, GQA_HEAD_DIM), k, v

    def merge(o):
        B, L = o.shape[:2]
        return o.reshape(B, L, qd) @ w_out

    scale = GQA_HEAD_DIM ** -0.5
    q, k, v = project(h, True)
    qc, kc, vc = project(hc, False)
    y = merge(block_attention(q, jnp.concatenate([k, kc], axis=1), jnp.concatenate([v, vc], axis=1), scale))
    yc = merge(block_attention(qc, kc, vc, scale)) if ctx_out else None
    return y, yc


def mla_mixer(h, hc, w_in, q_gain, kv_gain, w_qb, w_kvb, w_out, cos, sin, ctx_out):
    def project(t, rotate):
        B, L, _ = t.shape
        p = t @ w_in
        cq = rms_norm(p[..., :MLA_Q_LORA], q_gain)
        ckv = rms_norm(p[..., MLA_Q_LORA:MLA_Q_LORA + MLA_KV_LORA], kv_gain)
        k_rope = p[..., MLA_Q_LORA + MLA_KV_LORA:]
        q = (cq @ w_qb).reshape(B, L, MLA_HEADS, MLA_NOPE + MLA_ROPE)
        kv = (ckv @ w_kvb).reshape(B, L, MLA_HEADS, MLA_NOPE + MLA_V)
        q_nope, q_rope = q[..., :MLA_NOPE], q[..., MLA_NOPE:]
        k_nope, v = kv[..., :MLA_NOPE], kv[..., MLA_NOPE:]
        if rotate:
            q_rope = apply_rope(q_rope, cos[:, None, :], sin[:, None, :])
            k_rope = apply_rope(k_rope, cos, sin)
        q = jnp.concatenate([q_nope, q_rope], axis=-1)[:, :, :, None, :]
        k = jnp.concatenate([k_nope, jnp.broadcast_to(k_rope[:, :, None, :], (B, L, MLA_HEADS, MLA_ROPE))], axis=-1)
        return q, k, v

    def merge(o):
        B, L = o.shape[:2]
        return o.reshape(B, L, MLA_HEADS * MLA_V) @ w_out

    scale = (MLA_NOPE + MLA_ROPE) ** -0.5
    q, k, v = project(h, True)
    qc, kc, vc = project(hc, False)
    y = merge(block_attention(q, jnp.concatenate([k, kc], axis=1), jnp.concatenate([v, vc], axis=1), scale))
    yc = merge(block_attention(qc, kc, vc, scale)) if ctx_out else None
    return y, yc


def gla_chunk_scan(q, k, v, log_f, state0):
    B, L, H, _ = q.shape
    dv = v.shape[-1]
    n = L // HGRN_CHUNK

    def to_chunks(a):
        return a.reshape(B, n, HGRN_CHUNK, H, a.shape[-1]).transpose(1, 0, 3, 2, 4)

    incl = jnp.tril(jnp.ones((HGRN_CHUNK, HGRN_CHUNK), dtype=bool))[:, :, None]

    def step(state, inp):
        qc, kc, vc, gc = inp
        cum = jnp.cumsum(gc, axis=2)
        diff = cum[:, :, :, None, :] - cum[:, :, None, :, :]
        decay = jnp.where(incl, jnp.exp(jnp.where(incl, diff, 0.0)), 0.0)
        scores = jnp.einsum('bhtd,bhsd,bhtsd->bhts', qc, kc, decay)
        out = jnp.einsum('bhts,bhsv->bhtv', scores, vc) + jnp.einsum('bhtd,bhdv->bhtv', qc * jnp.exp(cum), state)
        cum_end = cum[:, :, -1, :]
        state = jnp.exp(cum_end)[..., None] * state + jnp.einsum(
            'bhsd,bhsv->bhdv', kc * jnp.exp(cum_end[:, :, None, :] - cum), vc)
        return state, out

    state, out = lax.scan(step, state0, (to_chunks(q), to_chunks(k), to_chunks(v), to_chunks(log_f)))
    return out.transpose(1, 0, 3, 2, 4).reshape(B, L, H, dv), state


def hgrn_mixer(h, hc, w_in, o_gain, w_out, lower_bound, ctx_out):
    lb = lower_bound.reshape(HGRN_HEADS, HGRN_DK)
    scale = HGRN_DK ** -0.5

    def project(t):
        B, L, _ = t.shape
        p = (t @ w_in).astype(jnp.float32).reshape(B, L, 5, HGRN_HEADS, HGRN_DK)
        q, inp, f_fwd_pre, f_bwd_pre, gate = p[:, :, 0], p[:, :, 1], p[:, :, 2], p[:, :, 3], p[:, :, 4]
        f_fwd = lb + (1.0 - lb) * jax.nn.sigmoid(f_fwd_pre)
        f_bwd = lb + (1.0 - lb) * jax.nn.sigmoid(f_bwd_pre)
        return q * scale, inp, 1.0 - f_fwd, jnp.log(f_fwd), 1.0 - f_bwd, jnp.log(f_bwd), gate

    def flip(a):
        return jnp.flip(a, axis=1)

    def readout(o, gate, dtype):
        B, L = o.shape[:2]
        return (rms_norm(o, o_gain) * jax.nn.silu(gate)).reshape(B, L, HGRN_WIDTH).astype(dtype) @ w_out

    q, i_, kf, gf, kb, gb, g = project(h)
    qc, ic, kfc, gfc, kbc, gbc, gc = project(hc)
    state0 = jnp.zeros((h.shape[0], HGRN_HEADS, HGRN_DK, HGRN_DV), jnp.float32)
    oc_f, s_f = gla_chunk_scan(qc, kfc, ic, gfc, state0)
    oc_b, s_b = gla_chunk_scan(flip(qc), flip(kbc), flip(ic), flip(gbc), state0)
    o_f, _ = gla_chunk_scan(q, kf, i_, gf, s_f)
    o_b, _ = gla_chunk_scan(flip(q), flip(kb), flip(i_), flip(gb), s_b)
    y = readout(o_f + flip(o_b), g, h.dtype)
    yc = readout(oc_f + flip(oc_b), gc, hc.dtype) if ctx_out else None
    return y, yc


def setup_inputs(seed: int = 0) -> dict:
    key = jax.random.key(seed)
    ks = jax.random.split(key, 28)

    def nrm(k, shape, s):
        return jax.random.normal(k, shape, jnp.float32) * s

    D = D_MODEL
    return {
        'x': nrm(ks[0], (BATCH, SEQ, D), 1.0),
        'c': nrm(ks[1], (BATCH, D), 1.0),
        'ctx': nrm(ks[2], (BATCH, CTX_LEN, D), 1.0),
        'c_ctx': nrm(ks[3], (D,), 1.0),
        'w_ada': nrm(ks[4], (DEPTH, D, 6 * D), 0.5 * D ** -0.5),
        'b_ada': nrm(ks[5], (DEPTH, 6 * D), 0.01),
        'norm_mix': 1.0 + nrm(ks[6], (DEPTH, D), 0.02),
        'norm_ffn': 1.0 + nrm(ks[7], (DEPTH, D), 0.02),
        'ffn_w_in': nrm(ks[8], (DEPTH, D, 2 * D_FF), D ** -0.5),
        'ffn_conv_w': nrm(ks[9], (DEPTH, CONV_W, 2 * D_FF), CONV_W ** -0.5),
        'ffn_conv_b': nrm(ks[10], (DEPTH, 2 * D_FF), 0.01),
        'ffn_w_out': nrm(ks[11], (DEPTH, D_FF, D), D_FF ** -0.5),
        'gqa_w_in': nrm(ks[12], (N_GQA, D, (GQA_Q_HEADS + 2 * GQA_KV_HEADS) * GQA_HEAD_DIM), D ** -0.5),
        'gqa_q_norm': 1.0 + nrm(ks[13], (N_GQA, GQA_HEAD_DIM), 0.02),
        'gqa_k_norm': 1.0 + nrm(ks[14], (N_GQA, GQA_HEAD_DIM), 0.02),
        'gqa_w_out': nrm(ks[15], (N_GQA, GQA_Q_HEADS * GQA_HEAD_DIM, D), (GQA_Q_HEADS * GQA_HEAD_DIM) ** -0.5),
        'hgrn_w_in': nrm(ks[16], (N_HGRN, D, 5 * HGRN_WIDTH), D ** -0.5),
        'hgrn_out_norm': 1.0 + nrm(ks[17], (N_HGRN, HGRN_DV), 0.02),
        'hgrn_w_out': nrm(ks[18], (N_HGRN, HGRN_WIDTH, D), HGRN_WIDTH ** -0.5),
        'hgrn_lower_bounds': nrm(ks[19], (DEPTH, HGRN_WIDTH), 0.5),
        'mla_w_in': nrm(ks[20], (N_MLA, D, MLA_Q_LORA + MLA_KV_LORA + MLA_ROPE), D ** -0.5),
        'mla_q_norm': 1.0 + nrm(ks[21], (N_MLA, MLA_Q_LORA), 0.02),
        'mla_kv_norm': 1.0 + nrm(ks[22], (N_MLA, MLA_KV_LORA), 0.02),
        'mla_w_qb': nrm(ks[23], (N_MLA, MLA_Q_LORA, MLA_HEADS * (MLA_NOPE + MLA_ROPE)), MLA_Q_LORA ** -0.5),
        'mla_w_kvb': nrm(ks[24], (N_MLA, MLA_KV_LORA, MLA_HEADS * (MLA_NOPE + MLA_V)), MLA_KV_LORA ** -0.5),
        'mla_w_out': nrm(ks[25], (N_MLA, MLA_HEADS * MLA_V, D), (MLA_HEADS * MLA_V) ** -0.5),
        'final_norm': 1.0 + nrm(ks[26], (D,), 0.02),
    }


def reference(x, c, ctx, c_ctx, w_ada, b_ada, norm_mix, norm_ffn, ffn_w_in, ffn_conv_w, ffn_conv_b, ffn_w_out,
              gqa_w_in, gqa_q_norm, gqa_k_norm, gqa_w_out, hgrn_w_in, hgrn_out_norm, hgrn_w_out, hgrn_lower_bounds,
              mla_w_in, mla_q_norm, mla_kv_norm, mla_w_qb, mla_w_kvb, mla_w_out, final_norm):
    rows = x.shape[1] // GRID_W
    cos_a, sin_a = axial_rope_tables(rows, GQA_HEAD_DIM)
    cos_m, sin_m = axial_rope_tables(rows, MLA_ROPE)
    lb_all = jnp.cumsum(jax.nn.softmax(hgrn_lower_bounds.astype(jnp.float32), axis=0), axis=0)
    lb_all = lb_all - lb_all[0]
    silu_c = jax.nn.silu(c)
    silu_cc = jax.nn.silu(c_ctx)

    for i in range(DEPTH):
        last = i == DEPTH - 1
        kind = i % N_MIXERS
        j = i // N_MIXERS
        mod = (silu_c @ w_ada[i] + b_ada[i])[:, None, :]
        mod_c = silu_cc @ w_ada[i] + b_ada[i]
        sh_a, sc_a, g_a, sh_f, sc_f, g_f = jnp.split(mod, 6, axis=-1)
        csh_a, csc_a, cg_a, csh_f, csc_f, cg_f = jnp.split(mod_c, 6, axis=-1)

        h = modulate(rms_norm(x, norm_mix[i]), sh_a, sc_a)
        hc = modulate(rms_norm(ctx, norm_mix[i]), csh_a, csc_a)
        if kind == 0:
            y, yc = gqa_mixer(h, hc, gqa_w_in[j], gqa_q_norm[j], gqa_k_norm[j], gqa_w_out[j],
                              cos_a, sin_a, not last)
        elif kind == 1:
            y, yc = hgrn_mixer(h, hc, hgrn_w_in[j], hgrn_out_norm[j], hgrn_w_out[j], lb_all[i], not last)
        else:
            y, yc = mla_mixer(h, hc, mla_w_in[j], mla_q_norm[j], mla_kv_norm[j], mla_w_qb[j], mla_w_kvb[j],
                              mla_w_out[j], cos_m, sin_m, not last)
        x = x + g_a * y
        x = x + g_f * conv_ffn(modulate(rms_norm(x, norm_ffn[i]), sh_f, sc_f),
                               ffn_w_in[i], ffn_conv_w[i], ffn_conv_b[i], ffn_w_out[i])
        if not last:
            ctx = ctx + cg_a * yc
            ctx = ctx + cg_f * conv_ffn(modulate(rms_norm(ctx, norm_ffn[i]), csh_f, csc_f),
                                        ffn_w_in[i], ffn_conv_w[i], ffn_conv_b[i], ffn_w_out[i])

    return rms_norm(x, final_norm)
```

```cpp
#include <hip/hip_runtime.h>
#include <hip/hip_bf16.h>
#include <hip/hip_cooperative_groups.h>
#include <cstdio>
#include <cstdint>
namespace cg = cooperative_groups;

namespace pg8 {
#define PG8_LAS __attribute__((address_space(3)))
typedef unsigned short bf16_t;
typedef short bf16x8 __attribute__((ext_vector_type(8)));
typedef float f32x4 __attribute__((ext_vector_type(4)));
typedef unsigned u32x4 __attribute__((ext_vector_type(4)));
typedef unsigned u32x2 __attribute__((ext_vector_type(2)));
constexpr int BM = 256, BK = 64, HALF = 128, HTB = HALF * BK * 2, STAGE_BYTES = 8 * HTB, NXCD = 8, WGM = 8;

__host__ __device__ __forceinline__ int lds_byte(int r, int c) { const int st = (r >> 4) * 2 + (c >> 5), rr = r & 15, cc = c & 31, ob = rr * 64 + cc * 2; return st * 1024 + (ob ^ (((ob >> 9) & 1) << 5)); }
__host__ __device__ __forceinline__ void stage_rc(int b, int& R, int& C) { const int st = b / 1024, sb = b % 1024, swz = sb ^ (((sb >> 9) & 1) << 5); R = (st >> 1) * 16 + swz / 64; C = (st & 1) * 32 + (swz % 64) / 2; }
__host__ __device__ __forceinline__ int perm32(int rho) { const int n = rho >> 4, i = rho & 15; return 8 * (i >> 2) + 4 * n + (i & 3); }

struct Unit { int pm, pn; };
struct Gemm { const bf16_t* A; const bf16_t* Bt; int M, N, K; };

struct StaticOrder {
    int nM, nN, nwg, G, c;
    __host__ __device__ void init(int M, int N, int G_, int c_) { nM = M / BM; nN = N / BM; nwg = nM * nN; G = G_; c = c_; }
    __host__ __device__ bool next(int i, Unit& u) const {
        const long L = (long)i * G + c; if (L >= nwg) return false;
        int wgid = (int)L; { const int q = nwg / NXCD, r = nwg % NXCD, xcd = wgid % NXCD, off = wgid / NXCD; wgid = (xcd < r ? xcd * (q + 1) : r * (q + 1) + (xcd - r) * q) + off; }
        const int nig = WGM * nN, gid = wgid / nig, fm = gid * WGM, gsz = (nM - fm) < WGM ? (nM - fm) : WGM;
        u.pm = fm + ((wgid % nig) % gsz); u.pn = (wgid % nig) / gsz; return true;
    }
    __device__ __forceinline__ void a_ready(const Unit&) const {}
    __device__ __forceinline__ void done(const Unit&) const {}
    __device__ __forceinline__ size_t a_off(const Unit& u, size_t tstep) const { return (size_t)u.pm * tstep; }
};

__device__ __forceinline__ unsigned cvt_pk_bf16(float lo, float hi) { unsigned r; asm volatile("v_cvt_pk_bf16_f32 %0, %1, %2" : "=v"(r) : "v"(lo), "v"(hi)); return r; }


template <class Epi, class Sched, bool ALIGN_EPI = false, bool SP2 = false>
__device__ __forceinline__ void gemm_phase(PG8_LAS unsigned char* lds, const Gemm g, const Sched& S, const Epi& E) {
    int tid_ = threadIdx.x; asm volatile("" : "+v"(tid_));
    const int tid = tid_, wid = __builtin_amdgcn_readfirstlane(tid >> 6), lane = tid & 63, wr = wid >> 2, wc = wid & 3, fr = lane & 15, fq = lane >> 4;
    const int K = g.K, nt = K / BK;
    unsigned voffA[2], voffB[2];
#pragma unroll
    for (int i = 0; i < 2; ++i) { int R, C; stage_rc(tid * 16 + i * 8192, R, C); const int Rb = Epi::PERM ? ((R & ~31) + perm32(R & 31)) : R;
        voffA[i] = (unsigned)(R * K + C) * 2u; voffB[i] = (unsigned)(Rb * K + C) * 2u; }
    const size_t kstep = (size_t)(BK * 2);
    const size_t hstep = (size_t)HALF * K * 2;
    const size_t tstep = 2 * hstep;
    const unsigned ldsw = (unsigned)wid * 1024u;
    const int aoff = lds_byte(wr * 64 + fr, fq * 8), boff = lds_byte(wc * 32 + fr, fq * 8);
#define PG8_SA(b, h) (((b) * 2 + (h)) * HTB)
#define PG8_SB(b, h) ((4 + (b) * 2 + (h)) * HTB)
#define PG8_STAGE(bufoff, gbase, voff) do { _Pragma("unroll") for (int _i = 0; _i < 2; ++_i) \
        __builtin_amdgcn_global_load_lds((const unsigned*)((const char*)(gbase) + (voff)[_i]), (PG8_LAS unsigned*)(lds + (bufoff) + ldsw + _i * 8192), 16, 0, 0); } while (0)
#define PG8_LDA(dst, b, h) do { _Pragma("unroll") for (int m = 0; m < 4; ++m) _Pragma("unroll") for (int k = 0; k < 2; ++k) dst[m][k] = *(const PG8_LAS bf16x8*)(lds + PG8_SA(b, h) + aoff + m * 2048 + k * 1024); } while (0)
#define PG8_LDB(dst, b, h) do { _Pragma("unroll") for (int n = 0; n < 2; ++n) _Pragma("unroll") for (int k = 0; k < 2; ++k) dst[n][k] = *(const PG8_LAS bf16x8*)(lds + PG8_SB(b, h) + boff + n * 2048 + k * 1024); } while (0)
#define PG8_MMA(ai, bj, At, Bt) do { __builtin_amdgcn_s_setprio(1); _Pragma("unroll") for (int m = 0; m < 4; ++m) _Pragma("unroll") for (int n = 0; n < 2; ++n) _Pragma("unroll") for (int k = 0; k < 2; ++k) \
        acc[ai][bj][m][n] = __builtin_amdgcn_mfma_f32_16x16x32_bf16(Bt[n][k], At[m][k], acc[ai][bj][m][n], 0, 0, 0); __builtin_amdgcn_s_setprio(0); } while (0)
#define PG8_WAIT_V(n) asm volatile("s_waitcnt vmcnt(" #n ")" ::: "memory")
#define PG8_WAIT_L(n) asm volatile("s_waitcnt lgkmcnt(" #n ")" ::: "memory")
#define PG8_BAR __builtin_amdgcn_s_barrier()
#define PG8_SCHED __builtin_amdgcn_sched_barrier(0)
    Unit cur, nxt; int ui = 0;
    if (!S.next(0, cur)) return;
    f32x4 acc[2][2][4][2];
#pragma unroll
    for (int a = 0; a < 2; ++a)
#pragma unroll
        for (int b = 0; b < 2; ++b)
#pragma unroll
            for (int m = 0; m < 4; ++m)
#pragma unroll
                for (int n = 0; n < 2; ++n) acc[a][b][m][n] = (f32x4){0.f, 0.f, 0.f, 0.f};
    bf16x8 At[4][2], B0[2][2], B1[2][2];
    const char* cA = (const char*)g.A + S.a_off(cur, tstep); const char* cB = (const char*)g.Bt + (size_t)cur.pn * tstep;
    S.a_ready(cur);
    if constexpr (SP2) {
        PG8_STAGE(PG8_SB(0, 0), cB, voffB); PG8_STAGE(PG8_SB(0, 1), cB + hstep, voffB); PG8_STAGE(PG8_SA(0, 0), cA, voffA); PG8_STAGE(PG8_SA(0, 1), cA + hstep, voffA);
        if (wr == 1) PG8_BAR;
        PG8_WAIT_V(2); PG8_BAR;
        PG8_STAGE(PG8_SB(1, 0), cB + kstep, voffB); PG8_STAGE(PG8_SA(1, 0), cA + kstep, voffA); PG8_STAGE(PG8_SB(1, 1), cB + hstep + kstep, voffB);
        PG8_WAIT_V(6); PG8_BAR;
    } else {
        PG8_STAGE(PG8_SB(0, 0), cB, voffB); PG8_STAGE(PG8_SA(0, 0), cA, voffA); PG8_STAGE(PG8_SB(0, 1), cB + hstep, voffB); PG8_STAGE(PG8_SA(0, 1), cA + hstep, voffA);
        if (wr == 1) PG8_BAR;
        PG8_WAIT_V(4); PG8_BAR;
        PG8_STAGE(PG8_SB(1, 0), cB + kstep, voffB); PG8_STAGE(PG8_SA(1, 0), cA + kstep, voffA); PG8_STAGE(PG8_SB(1, 1), cB + hstep + kstep, voffB);
        PG8_WAIT_V(6); PG8_BAR;
    }
    for (;;) {
        const bool has_next = S.next(ui + 1, nxt);
        const char* nA = has_next ? (const char*)g.A + S.a_off(nxt, tstep) : cA; const char* nB = has_next ? (const char*)g.Bt + (size_t)nxt.pn * tstep : cB;
        for (int t = 0; t < nt; t += 2) {
            const bool last = (t == nt - 2);
            const char* a1 = cA + (size_t)(t + 1) * kstep;
            const char* a2 = last ? nA : cA + (size_t)(t + 2) * kstep; const char* b2 = last ? nB : cB + (size_t)(t + 2) * kstep;
            const char* a3 = a2 + kstep; const char* b3 = b2 + kstep;
            if (last && has_next) S.a_ready(nxt);
            if constexpr (SP2) {
            PG8_LDB(B0, 0, 0); PG8_LDB(B1, 0, 1); PG8_SCHED; PG8_LDA(At, 0, 0); PG8_STAGE(PG8_SA(1, 1), a1 + hstep, voffA);
            PG8_WAIT_V(8); PG8_WAIT_L(0); PG8_BAR; PG8_MMA(0, 0, At, B0); PG8_MMA(0, 1, At, B1); PG8_BAR; PG8_SCHED;
            PG8_LDA(At, 0, 1); PG8_STAGE(PG8_SB(0, 0), b2, voffB); PG8_STAGE(PG8_SB(0, 1), b2 + hstep, voffB); PG8_STAGE(PG8_SA(0, 0), a2, voffA);
            PG8_WAIT_V(8); PG8_WAIT_L(0); PG8_BAR; PG8_MMA(1, 0, At, B0); PG8_MMA(1, 1, At, B1); PG8_BAR; PG8_SCHED;
            PG8_LDB(B0, 1, 0); PG8_LDB(B1, 1, 1); PG8_SCHED; PG8_LDA(At, 1, 0); PG8_STAGE(PG8_SA(0, 1), a2 + hstep, voffA);
            PG8_WAIT_V(8); PG8_WAIT_L(0); PG8_BAR; PG8_MMA(0, 0, At, B0); PG8_MMA(0, 1, At, B1); PG8_BAR; PG8_SCHED;
            PG8_LDA(At, 1, 1); PG8_STAGE(PG8_SB(1, 0), b3, voffB); PG8_STAGE(PG8_SB(1, 1), b3 + hstep, voffB); PG8_STAGE(PG8_SA(1, 0), a3, voffA);
            PG8_WAIT_V(8); PG8_WAIT_L(0); PG8_BAR; PG8_MMA(1, 0, At, B0); PG8_MMA(1, 1, At, B1); PG8_BAR; PG8_SCHED;
            } else {
            PG8_LDB(B0, 0, 0); PG8_SCHED; PG8_LDA(At, 0, 0); PG8_STAGE(PG8_SA(1, 1), a1 + hstep, voffA);
            PG8_WAIT_L(8); PG8_BAR; PG8_WAIT_L(0); PG8_MMA(0, 0, At, B0); PG8_BAR; PG8_SCHED;
            PG8_LDB(B1, 0, 1); PG8_STAGE(PG8_SB(0, 0), b2, voffB);
            PG8_BAR; PG8_WAIT_L(0); PG8_MMA(0, 1, At, B1); PG8_BAR;
            PG8_LDA(At, 0, 1); PG8_STAGE(PG8_SA(0, 0), a2, voffA);
            PG8_BAR; PG8_WAIT_L(0); PG8_MMA(1, 0, At, B0); PG8_BAR; PG8_SCHED;
            PG8_STAGE(PG8_SB(0, 1), b2 + hstep, voffB);
            PG8_WAIT_V(6); PG8_BAR; PG8_MMA(1, 1, At, B1); PG8_BAR;
            PG8_LDB(B0, 1, 0); PG8_SCHED; PG8_LDA(At, 1, 0); PG8_STAGE(PG8_SA(0, 1), a2 + hstep, voffA);
            PG8_WAIT_L(8); PG8_BAR; PG8_WAIT_L(0); PG8_MMA(0, 0, At, B0); PG8_BAR; PG8_SCHED;
            PG8_LDB(B1, 1, 1); PG8_STAGE(PG8_SB(1, 0), b3, voffB);
            PG8_BAR; PG8_WAIT_L(0); PG8_MMA(0, 1, At, B1); PG8_BAR;
            PG8_LDA(At, 1, 1); PG8_STAGE(PG8_SA(1, 0), a3, voffA);
            PG8_BAR; PG8_WAIT_L(0); PG8_MMA(1, 0, At, B0); PG8_BAR; PG8_SCHED;
            PG8_STAGE(PG8_SB(1, 1), b3 + hstep, voffB);
            PG8_WAIT_V(6); PG8_BAR; PG8_MMA(1, 1, At, B1); PG8_BAR;
            }
        }
        if constexpr (ALIGN_EPI) { if (wr == 0) PG8_BAR; }
        E(acc, cur, wr, wc, fr, fq); S.done(cur);
        if (!has_next) break;
#pragma unroll
        for (int a = 0; a < 2; ++a)
#pragma unroll
            for (int b = 0; b < 2; ++b)
#pragma unroll
                for (int m = 0; m < 4; ++m)
#pragma unroll
                    for (int n = 0; n < 2; ++n) acc[a][b][m][n] = (f32x4){0.f, 0.f, 0.f, 0.f};
        cur = nxt; cA = nA; cB = nB; ++ui;
        if constexpr (ALIGN_EPI) { if (wr == 1) PG8_BAR; }
    }
    PG8_WAIT_V(0);
    if constexpr (!ALIGN_EPI) { if (wr == 0) PG8_BAR; }
    PG8_BAR;
#undef PG8_SA
#undef PG8_SB
#undef PG8_STAGE
#undef PG8_LDA
#undef PG8_LDB
#undef PG8_MMA
#undef PG8_WAIT_V
#undef PG8_WAIT_L
#undef PG8_BAR
#undef PG8_SCHED
}
}

typedef unsigned short bf16_t;
typedef short bf16x8 __attribute__((ext_vector_type(8)));
typedef short s16x4 __attribute__((ext_vector_type(4)));
typedef float f32x16 __attribute__((ext_vector_type(16)));
typedef float f32x4 __attribute__((ext_vector_type(4)));
typedef float f32x2 __attribute__((ext_vector_type(2)));
typedef unsigned u32x4 __attribute__((ext_vector_type(4)));
typedef unsigned u32x2 __attribute__((ext_vector_type(2)));
#define LAS __attribute__((address_space(3)))

constexpr int D = 1024, SEQ = 8192, CTXL = 256, RB = SEQ + CTXL  , M = 2 * RB  ;
constexpr int DFF = 3072;
constexpr float EPS = 1e-6f;
constexpr int NTHREADS = 512, NWAVES = 8;
constexpr int LDS_BYTES = 147456;
#ifndef DUPM
#define DUPM 0x0
#endif
#ifndef XSYNC
#define XSYNC 0
#endif
#define PH(b) _Pragma("unroll 1") for (int rep_ = 0; rep_ < ((((DUPM) >> (b)) & 1) ? 2 : 1); ++rep_)

constexpr size_t MiB = 1u << 20;
constexpr size_t WS_MOD = 0;
constexpr size_t WS_LB = 512 * 1024;
constexpr size_t WS_TA = 576 * 1024;
constexpr size_t WS_TM = 640 * 1024;
constexpr size_t WS_BAR = 1 * MiB;
constexpr size_t WS_BAR_BYTES = 16384;
constexpr int MISC_OFF = 131072 + 320;
constexpr size_t WS_XC = 2 * MiB;
constexpr size_t WS_WM = 4 * MiB;
constexpr size_t WS_WF = 17 * MiB;
constexpr size_t WS_XN = 36 * MiB;
constexpr size_t WS_U = 70 * MiB;
constexpr size_t WS_G = 270 * MiB;
constexpr size_t WS_END = 370 * MiB;

constexpr int XNF_BSTRIDE = 8450, XNF_ROWS = 16900 + 257;
__device__ __forceinline__ int xnf_row(int b, int t) { return b * XNF_BSTRIDE + t + 1 + (t >= SEQ ? 1 : 0); }
__device__ __forceinline__ void zero_xnf_guards(unsigned short* XNFb, int tid) {
    if (blockIdx.x != 0) return;
    const __attribute__((ext_vector_type(4))) unsigned z = {0u, 0u, 0u, 0u};
    for (int idx = tid; idx < (4 + 257) * 128; idx += 512) { const int q = idx >> 7, c16 = idx & 127;
        const int row = q == 0 ? 0 : (q == 1 ? 8193 : (q == 2 ? 8450 : (q == 3 ? 16643 : 16900 + (q - 4))));
        *(__attribute__((ext_vector_type(4))) unsigned*)(XNFb + (size_t)row * 1024 + c16 * 8) = z; }
}
__device__ __forceinline__ float bflo(unsigned w) { return __uint_as_float(w << 16); }
__device__ __forceinline__ float bfhi(unsigned w) { return __uint_as_float(w & 0xffff0000u); }
__device__ __forceinline__ float bf2f(bf16_t b) { return __uint_as_float((unsigned)b << 16); }
typedef __bf16 bf16x2_t __attribute__((ext_vector_type(2)));
__device__ __forceinline__ unsigned pk2(float lo, float hi) { f32x2 v = {lo, hi}; bf16x2_t b = __builtin_convertvector(v, bf16x2_t); return __builtin_bit_cast(unsigned, b); }
__device__ __forceinline__ float wave_sum(float v) {
#pragma unroll
    for (int o = 1; o < 64; o <<= 1) v += __shfl_xor(v, o);
    return v;
}
__device__ __forceinline__ float sum16(float v) { v += __shfl_xor(v, 1); v += __shfl_xor(v, 2); v += __shfl_xor(v, 4); v += __shfl_xor(v, 8); return v; }
__device__ __forceinline__ float silu_f(float v) { return v * __builtin_amdgcn_rcpf(1.f + __expf(-v)); }
__device__ __forceinline__ float sigmoid_f(float v) { return __builtin_amdgcn_rcpf(1.f + __expf(-v)); }


#define XB_TMO      128
#define XB_XCNT(j)  (256  + 64 * (j))
#define XB_XSUB(j)  (1280 + 64 * (j))
#define XB_XGEN(j)  (2304 + 64 * (j))
#define XB_TOP      3328
#define XB_TOPGEN   3392
#define XCD_BAR_WORDS 3456
#define XB_SPIN_CAP (1u << 18)
__device__ __forceinline__ unsigned xb_ld(unsigned* p)              { return __hip_atomic_load(p, __ATOMIC_RELAXED, __HIP_MEMORY_SCOPE_AGENT); }
__device__ __forceinline__ unsigned xb_add(unsigned* p, unsigned v) { return __hip_atomic_fetch_add(p, v, __ATOMIC_RELAXED, __HIP_MEMORY_SCOPE_AGENT); }
__device__ __forceinline__ unsigned xb_xcc_id() { return (unsigned)__builtin_amdgcn_s_getreg((3 << 11) | 20) & 0xFu; }
#define XB_SPIN(cond, bar) do { unsigned _sp = 0; while (cond) { __builtin_amdgcn_s_sleep(1); \
    if ((++_sp & 255u) == 0u) { if (xb_ld(&(bar)[XB_TMO])) break; if (_sp > XB_SPIN_CAP) { atomicAdd(&(bar)[XB_TMO], 1u); break; } } } } while (0)
struct XcdBarrier { unsigned* bar; unsigned x; volatile LAS unsigned* st; };
__device__ __forceinline__ XcdBarrier xcd_barrier_post(unsigned* bar, volatile LAS unsigned* st) {
    XcdBarrier b; b.bar = bar; b.x = xb_xcc_id(); b.st = st;
    if (threadIdx.x == 0) (void)xb_add(&bar[XB_XCNT(b.x)], 1u);
    return b;
}
__device__ __forceinline__ void xcd_barrier_complete(unsigned* bar, unsigned x, unsigned& nloc, unsigned& nx) {
    const unsigned G = gridDim.x * gridDim.y * gridDim.z;
    unsigned sum, cnt, mine, sp = 0u;
    for (;;) {
        sum = 0u; cnt = 0u; mine = 0u;
#pragma unroll
        for (unsigned j = 0; j < 16; ++j) { const unsigned c = xb_ld(&bar[XB_XCNT(j)]); sum += c; cnt += (c > 0u) ? 1u : 0u; mine = (j == x) ? c : mine; }
        if (sum == G) break;
        __builtin_amdgcn_s_sleep(1);
        if ((++sp & 255u) == 0u) { if (xb_ld(&bar[XB_TMO])) break; if (sp > XB_SPIN_CAP) { atomicAdd(&bar[XB_TMO], 1u); break; } }
    }
    nloc = mine > 0u ? mine : 1u; nx = cnt > 0u ? cnt : 1u;
}
__device__ __forceinline__ void xcd_barrier(const XcdBarrier& b) {
    asm volatile("s_waitcnt vmcnt(0)" ::: "memory");
    __syncthreads();
    if (threadIdx.x == 0) {
        unsigned* bar = b.bar;
        __builtin_amdgcn_s_waitcnt(0);
        unsigned nloc = b.st[0], nx = b.st[1];
        if (nloc == 0u) { xcd_barrier_complete(bar, b.x, nloc, nx); b.st[0] = nloc; b.st[1] = nx; }
        const unsigned old = xb_add(&bar[XB_XSUB(b.x)], 1u);
        const unsigned gen = old / nloc;
        if (old + 1u == (gen + 1u) * nloc) {
            __builtin_amdgcn_fence(__ATOMIC_RELEASE, "agent");
            asm volatile("s_waitcnt vmcnt(0)" ::: "memory");
            const unsigned og = xb_add(&bar[XB_TOP], 1u);
            const unsigned tg = og / nx;
            if (og + 1u == (tg + 1u) * nx) xb_add(&bar[XB_TOPGEN], 1u);
            else XB_SPIN(xb_ld(&bar[XB_TOPGEN]) == tg, bar);
            __builtin_amdgcn_fence(__ATOMIC_ACQUIRE, "agent");
            xb_add(&bar[XB_XGEN(b.x)], 1u);
            asm volatile("s_waitcnt vmcnt(0)" ::: "memory");
        } else {
            XB_SPIN(xb_ld(&bar[XB_XGEN(b.x)]) == gen, bar);
            __builtin_amdgcn_fence(__ATOMIC_ACQUIRE, "agent");
            asm volatile("s_waitcnt vmcnt(0)" ::: "memory");
        }
    }
    __syncthreads();
}

struct EpiStore {
    static constexpr bool PERM = true;
    bf16_t* O; int ldc;
    __device__ __forceinline__ void operator()(const f32x4 (&acc)[2][2][4][2], const pg8::Unit& u, int wr, int wc, int fr, int fq) const {
        bf16_t* base = O + (size_t)u.pm * 256 * ldc + u.pn * 256 + wc * 32;
        const int loff = (wr * 64 + fr) * ldc + 8 * fq;
#pragma unroll
        for (int ai = 0; ai < 2; ++ai)
#pragma unroll
            for (int m = 0; m < 4; ++m) {
#pragma unroll
                for (int bj = 0; bj < 2; ++bj) { const f32x4 v0 = acc[ai][bj][m][0], v1 = acc[ai][bj][m][1];
                    u32x4 w; w.x = pk2(v0[0], v0[1]); w.y = pk2(v0[2], v0[3]); w.z = pk2(v1[0], v1[1]); w.w = pk2(v1[2], v1[3]);
                    *(u32x4*)(base + loff + (ai * 128 + m * 16) * ldc + bj * 128) = w; } }
    }
};
struct EpiResid {
    static constexpr bool PERM = false;
    const float* slat; const float* sctx; float* dlat; float* dctx; const float* gate;
    __device__ __forceinline__ void operator()(const f32x4 (&acc)[2][2][4][2], const pg8::Unit& u, int wr, int wc, int fr, int fq) const {
        const int b = u.pm / 33, j = u.pm - b * 33;
        const size_t boff = (j < 32) ? ((size_t)b * SEQ + (size_t)j * 256) * D : (size_t)b * CTXL * D;
        const float* sb = (j < 32 ? slat : sctx) + boff; float* db = (j < 32 ? dlat : dctx) + boff;
        const float* g = gate + (j < 32 ? b : 2) * 6144 + u.pn * 256 + wc * 32;
        const int loff = (wr * 64 + fr) * D + u.pn * 256 + wc * 32 + 4 * fq;
#pragma unroll
        for (int bj = 0; bj < 2; ++bj)
#pragma unroll
            for (int n = 0; n < 2; ++n) { const f32x4 gv = *(const f32x4*)(g + 4 * fq + bj * 128 + n * 16);
#pragma unroll
                for (int ai = 0; ai < 2; ++ai)
#pragma unroll
                    for (int m = 0; m < 4; ++m) { const int off = loff + (ai * 128 + m * 16) * D + bj * 128 + n * 16;
                        const f32x4 x = *(const f32x4*)(sb + off); *(f32x4*)(db + off) = x + gv * acc[ai][bj][m][n]; }
                asm volatile("" ::: "memory"); }
    }
};
struct EpiMlaQ {
    static constexpr bool PERM = false;
    bf16_t* Qp; const float* TM;
    __device__ __forceinline__ void operator()(const f32x4 (&acc)[2][2][4][2], const pg8::Unit& u, int wr, int wc, int fr, int fq) const {
        const int b = u.pm / 33, j = u.pm - b * 33; const bool lat = j < 32;
#pragma unroll
        for (int bj = 0; bj < 2; ++bj) {
            const int blk = u.pn * 8 + bj * 4 + wc, h = blk / 3, part = blk - 3 * h;
#pragma unroll
            for (int ai = 0; ai < 2; ++ai)
#pragma unroll
                for (int m = 0; m < 4; ++m) { const int rl = ai * 128 + wr * 64 + m * 16 + fr; const size_t row = (size_t)u.pm * 256 + rl;
                    f32x4 v0 = acc[ai][bj][m][0], v1 = acc[ai][bj][m][1];
                    if (part == 2 && lat) { const int t = j * 256 + rl, ri = t >> 6, ci = t & 63;
#pragma unroll
                        for (int e = 0; e < 4; ++e) { const int jj = 4 * fq + e; const int pos = jj < 8 ? ri : ci; const f32x2 cs = *(const f32x2*)(TM + (pos * 8 + (jj & 7)) * 2);
                            const float x1 = v0[e], x2 = v1[e]; v0[e] = x1 * cs.x - x2 * cs.y; v1[e] = x1 * cs.y + x2 * cs.x; } }
                    bf16_t* p = Qp + row * 2048 + h * 128 + part * 32 + 4 * fq;
                    u32x2 w0; w0.x = pk2(v0[0], v0[1]); w0.y = pk2(v0[2], v0[3]); u32x2 w1; w1.x = pk2(v1[0], v1[1]); w1.y = pk2(v1[2], v1[3]);
                    *(u32x2*)p = w0; *(u32x2*)(p + 16) = w1; }
        }
    }
};
struct EpiMlaKV {
    static constexpr bool PERM = true;
    bf16_t* Kp; bf16_t* Vp;
    __device__ __forceinline__ void operator()(const f32x4 (&acc)[2][2][4][2], const pg8::Unit& u, int wr, int wc, int fr, int fq) const {
        bf16_t* base = ((wc < 2) ? Kp : Vp) + (size_t)u.pm * 256 * 2048 + u.pn * 256 + (wc & 1) * 32;
        const int loff = (wr * 64 + fr) * 2048 + 8 * fq;
#pragma unroll
        for (int ai = 0; ai < 2; ++ai)
#pragma unroll
            for (int m = 0; m < 4; ++m) {
#pragma unroll
                for (int bj = 0; bj < 2; ++bj) { const f32x4 v0 = acc[ai][bj][m][0], v1 = acc[ai][bj][m][1];
                    u32x4 w; w.x = pk2(v0[0], v0[1]); w.y = pk2(v0[2], v0[3]); w.z = pk2(v1[0], v1[1]); w.w = pk2(v1[2], v1[3]);
                    *(u32x4*)(base + loff + (ai * 128 + m * 16) * 2048 + bj * 128) = w; } }
    }
};

struct LatentOrder {
    pg8::StaticOrder so;
    __device__ void init(int N, int G, int c) { so.init(2 * SEQ, N, G, c); }
    __device__ bool next(int i, pg8::Unit& u) const { if (!so.next(i, u)) return false; u.pm += (u.pm >= 32) ? 1 : 0; return true; }
    __device__ __forceinline__ void a_ready(const pg8::Unit&) const {}
    __device__ __forceinline__ void done(const pg8::Unit&) const {}
    __device__ __forceinline__ size_t a_off(const pg8::Unit& u, size_t tstep) const { return (size_t)u.pm * tstep; }
};
template <int K>
__device__ __forceinline__ void ctx_resid_gemm(const bf16_t* __restrict__ A, const bf16_t* __restrict__ Bt, const float* sctx, float* dctx, const float* gate_ctx, char* lds, int tid) {
    const int wave = tid >> 6, lane = tid & 63, r32 = lane & 31, hi = lane >> 5;
    float* Pp = (float*)lds;
    for (int tile = blockIdx.x; tile < 256; tile += gridDim.x) {
        const int rt = tile >> 4, ct = tile & 15, crow0 = rt * 32, b = crow0 >> 8, within = crow0 & 255;
        const bf16_t* Ap = A + ((size_t)b * RB + SEQ + within + r32) * K + wave * (K / 8) + hi * 8;
        const bf16_t* Bp = Bt + ((size_t)ct * 64 + r32) * K + wave * (K / 8) + hi * 8;
        f32x16 acc0 = {}, acc1 = {};
#pragma unroll 8
        for (int kk = 0; kk < K / 8; kk += 16) {
            const bf16x8 a = *(const bf16x8*)(Ap + kk), b0 = *(const bf16x8*)(Bp + kk), b1 = *(const bf16x8*)(Bp + (size_t)32 * K + kk);
            acc0 = __builtin_amdgcn_mfma_f32_32x32x16_bf16(a, b0, acc0, 0, 0, 0);
            acc1 = __builtin_amdgcn_mfma_f32_32x32x16_bf16(a, b1, acc1, 0, 0, 0);
        }
#pragma unroll
        for (int r = 0; r < 16; ++r) { const int row = (r & 3) + 8 * (r >> 2) + 4 * hi; Pp[(wave * 32 + row) * 64 + r32] = acc0[r]; Pp[(wave * 32 + row) * 64 + 32 + r32] = acc1[r]; }
        __syncthreads();
        { const int row = tid >> 4, c4 = (tid & 15) * 4; f32x4 v = *(const f32x4*)(Pp + row * 64 + c4);
#pragma unroll
          for (int w = 1; w < 8; ++w) v += *(const f32x4*)(Pp + (w * 32 + row) * 64 + c4);
          const int col = ct * 64 + c4; const size_t off = (size_t)(crow0 + row) * D + col;
          const f32x4 g = *(const f32x4*)(gate_ctx + col), x = *(const f32x4*)(sctx + off);
          *(f32x4*)(dctx + off) = x + g * v; }
        __syncthreads();
    }
}

template <bool LASTL>
struct FfnOrder {
    pg8::StaticOrder so;
    __device__ void init(int G, int c) { so.init((LASTL ? 66 : 70) * 256, 6144, G, c); }
    __device__ bool next(int i, pg8::Unit& u) const { return so.next(i, u); }
    __device__ __forceinline__ void a_ready(const pg8::Unit&) const {}
    __device__ __forceinline__ void done(const pg8::Unit&) const {}
    __device__ __forceinline__ size_t a_off(const pg8::Unit& u, size_t tstep) const {
        int b, tt, isctx;
        if (LASTL) { b = u.pm / 33; tt = u.pm - b * 33; isctx = 0; } else { b = u.pm / 35; const int j = u.pm - b * 35; isctx = j >= 33; tt = isctx ? j - 33 : j; }
        const int row = b * XNF_BSTRIDE + (isctx ? SEQ + 1 : 0) + 254 * tt;
        return (size_t)row * (tstep / 256);
    }
};
template <int CTRL> __device__ __forceinline__ float dppf(float oldv, float src) {
    return __int_as_float(__builtin_amdgcn_update_dpp(__float_as_int(oldv), __float_as_int(src), CTRL, 0xf, 0xf, false));
}
template <bool LASTL>
struct EpiConvGate {
    static constexpr bool PERM = true;
    bf16_t* Gb; const float* cw; const float* cb; LAS float* H;
    __device__ __forceinline__ void operator()(const f32x4 (&acc)[2][2][4][2], const pg8::Unit& u, int wr, int wc, int fr, int fq) const {
        int b, tt, isctx;
        if (LASTL) { b = u.pm / 33; tt = u.pm - b * 33; isctx = 0; } else { b = u.pm / 35; const int j = u.pm - b * 35; isctx = j >= 33; tt = isctx ? j - 33 : j; }
        const int L = isctx ? CTXL : SEQ, mbase = b * RB + (isctx ? SEQ : 0), s0 = 254 * tt - 1;
        int frl = fr, fql = fq;
        asm volatile("" : "+v"(frl), "+v"(fql));
        const int cl = wc * 32 + 8 * fql;
        bf16_t* gbase = Gb + ((long)(mbase + s0) * DFF + u.pn * 128);
        { LAS float* sink = H + 3072 + ((wr * 4 + wc) * 64 + fql * 16 + frl) % 192 * 4;
#pragma unroll
          for (int ai = 0; ai < 2; ++ai) { const int B = ai * 2 + wr;
#pragma unroll
            for (int bj = 0; bj < 2; ++bj)
#pragma unroll
                for (int n = 0; n < 2; ++n) {
                    LAS float* p0 = (frl == 0) ? H + (((B * 2 + 0) * 2 + bj) * 128 + cl + 4 * n) : sink;
                    LAS float* p1 = (frl == 15) ? H + (((B * 2 + 1) * 2 + bj) * 128 + cl + 4 * n) : sink;
                    *(LAS f32x4*)p0 = acc[ai][bj][0][n]; *(LAS f32x4*)p1 = acc[ai][bj][3][n]; } } }
        LAS float* Wl = H + 2048;
        { const int tix = (wr * 4 + wc) * 64 + fql * 16 + frl;
          const int arr = tix >> 5, c4 = (tix & 31) * 4, so = (arr & 1) * 3072 + u.pn * 128 + c4;
          if (tix < 192) *(LAS f32x4*)(Wl + arr * 128 + c4) = *(const f32x4*)(cw + (arr >> 1) * 6144 + so);
          else if (tix < 256) *(LAS f32x4*)(Wl + arr * 128 + c4) = *(const f32x4*)(cb + so); }
        asm volatile("s_waitcnt vmcnt(0) lgkmcnt(0)" ::: "memory"); __builtin_amdgcn_s_barrier(); asm volatile("" ::: "memory");
#pragma unroll
        for (int n = 0; n < 2; ++n) {
#pragma unroll
            for (int ai = 0; ai < 2; ++ai) { const int B = ai * 2 + wr;
                const int Bp = B > 0 ? B - 1 : 0, Bn = B < 3 ? B + 1 : 3;
                unsigned lo[4];
#pragma unroll
                for (int ep = 0; ep < 2; ++ep) {
                    float g0[4];
#pragma unroll
                    for (int e1 = 0; e1 < 2; ++e1) { const int e = 2 * ep + e1; const LAS float* wp = Wl + cl + 4 * n + e; const LAS float* hp = H + cl + 4 * n + e;
                        const float wa0 = wp[0], wv0 = wp[128], wa1 = wp[256], wv1 = wp[384], wa2 = wp[512], wv2 = wp[640], ba = wp[768], bv = wp[896];
                        float pa[4], pv[4];
#pragma unroll
                        for (int m = 0; m < 4; ++m) { pa[m] = acc[ai][0][m][n][e]; pv[m] = acc[ai][1][m][n][e]; }
#pragma unroll
                        for (int m = 0; m < 4; ++m) {
                            const float pra = dppf<0x111>(m > 0 ? dppf<0x121>(0.f, pa[m - 1]) : hp[((Bp * 2 + 1) * 2 + 0) * 128], pa[m]), nxa = dppf<0x101>(m < 3 ? dppf<0x12F>(0.f, pa[m + 1]) : hp[((Bn * 2 + 0) * 2 + 0) * 128], pa[m]);
                            const float prv = dppf<0x111>(m > 0 ? dppf<0x121>(0.f, pv[m - 1]) : hp[((Bp * 2 + 1) * 2 + 1) * 128], pv[m]), nxv = dppf<0x101>(m < 3 ? dppf<0x12F>(0.f, pv[m + 1]) : hp[((Bn * 2 + 0) * 2 + 1) * 128], pv[m]);
                            const float av = ba + wa0 * pra + wa1 * pa[m] + wa2 * nxa, vv = bv + wv0 * prv + wv1 * pv[m] + wv2 * nxv;
                            const float gv = silu_f(av) * vv;
                            if (e1 == 0) g0[m] = gv;
                            else { const unsigned w = pk2(g0[m], gv);
                                if (ep == 0) lo[m] = w;
                                else { const int rl = B * 64 + m * 16 + frl, sq = s0 + rl;
                                    if (rl >= 1 && rl <= 254 && sq < L) { u32x2 w2; w2.x = lo[m]; w2.y = w; *(u32x2*)(gbase + (rl * DFF + cl + 4 * n)) = w2; } } } } }
                }
            }
        }
    }
};

struct EpiGqaQKV {
    static constexpr bool PERM = true;
    bf16_t* O; const float* qg; const float* kg; const float* TA; LAS float* Pn;
    __device__ __forceinline__ void operator()(const f32x4 (&acc)[2][2][4][2], const pg8::Unit& u, int wr, int wc, int fr, int fq) const {
        int frl = fr, fql = fq;
        asm volatile("" : "+v"(frl), "+v"(fql));
        bf16_t* base = O + (size_t)u.pm * 256 * 4096 + u.pn * 256 + wc * 32;
        const int loff = (wr * 64 + frl) * 4096 + 8 * fql;
        if (u.pn >= 12) {
#pragma unroll
            for (int ai = 0; ai < 2; ++ai)
#pragma unroll
                for (int m = 0; m < 4; ++m)
#pragma unroll
                    for (int bj = 0; bj < 2; ++bj) { const f32x4 v0 = acc[ai][bj][m][0], v1 = acc[ai][bj][m][1];
                        u32x4 w; w.x = pk2(v0[0], v0[1]); w.y = pk2(v0[2], v0[3]); w.z = pk2(v1[0], v1[1]); w.w = pk2(v1[2], v1[3]);
                        *(u32x4*)(base + loff + (ai * 128 + m * 16) * 4096 + bj * 128) = w; }
            return;
        }
#pragma unroll
        for (int ai = 0; ai < 2; ++ai)
#pragma unroll
            for (int m = 0; m < 4; ++m)
#pragma unroll
                for (int bj = 0; bj < 2; ++bj) { const f32x4 a = acc[ai][bj][m][0], c = acc[ai][bj][m][1];
                    float ss = (a[0] * a[0] + a[1] * a[1]) + (a[2] * a[2] + a[3] * a[3]) + (c[0] * c[0] + c[1] * c[1]) + (c[2] * c[2] + c[3] * c[3]);
                    ss += __shfl_xor(ss, 16); ss += __shfl_xor(ss, 32);
                    if (fql == 0) Pn[((ai * 128 + wr * 64 + m * 16 + frl) * 2 + bj) * 4 + wc] = ss; }
        asm volatile("s_waitcnt lgkmcnt(0)" ::: "memory"); __builtin_amdgcn_s_barrier(); asm volatile("" ::: "memory");
        const int b = u.pm / 33, jt = u.pm - b * 33; const bool lat = jt < 32;
        const float* gn = (u.pn < 8 ? qg : kg) + 16 * wc + 4 * fql;
        const f32x4 g1 = *(const f32x4*)gn, g2 = *(const f32x4*)(gn + 64);
#pragma unroll
        for (int ai = 0; ai < 2; ++ai)
#pragma unroll
            for (int m = 0; m < 4; ++m) { const int rl = ai * 128 + wr * 64 + m * 16 + frl; const int t = jt * 256 + rl, pos = (wc < 2) ? (t >> 6) : (t & 63);
                f32x2 cs[4];
#pragma unroll
                for (int e = 0; e < 4; ++e) cs[e] = lat ? *(const f32x2*)(TA + (pos * 32 + ((16 * wc + 4 * fql + e) & 31)) * 2) : (f32x2){1.f, 0.f};
#pragma unroll
                for (int bj = 0; bj < 2; ++bj) { const f32x4 p4 = *(const LAS f32x4*)(Pn + (rl * 2 + bj) * 4);
                    const float rs = rsqrtf(((p4.x + p4.y) + (p4.z + p4.w)) * (1.f / 128.f) + EPS);
                    const f32x4 x1 = acc[ai][bj][m][0], x2 = acc[ai][bj][m][1]; float o1[4], o2[4];
#pragma unroll
                    for (int e = 0; e < 4; ++e) { const float y1 = x1[e] * rs * g1[e], y2 = x2[e] * rs * g2[e]; o1[e] = y1 * cs[e].x - y2 * cs[e].y; o2[e] = y1 * cs[e].y + y2 * cs[e].x; }
                    u32x4 w; w.x = pk2(o1[0], o1[1]); w.y = pk2(o1[2], o1[3]); w.z = pk2(o2[0], o2[1]); w.w = pk2(o2[2], o2[3]);
                    *(u32x4*)(base + loff + (ai * 128 + m * 16) * 4096 + bj * 128) = w; } }
    }
};

namespace att {
constexpr int NW = 8, QBLK = 32, KVBLK = 64;
constexpr float THR = 8.f;
constexpr size_t SHM_V = KVBLK * 128 * 2, SHM_K = KVBLK * 128 * 2, SHM_ATTN = 2 * SHM_V + 2 * SHM_K + NW * 64 * 4;
#define KSWZ(row, colB) ((row) * 256 + ((colB) ^ (((row) & 7) << 4)))
#define SBAR() __builtin_amdgcn_sched_barrier(0)
__device__ __forceinline__ int crow(int r, int hi) { return (r & 3) + 8 * (r >> 2) + 4 * hi; }
__device__ __forceinline__ unsigned cvtpk(float lo, float hi) { unsigned r; asm volatile("v_cvt_pk_bf16_f32 %0, %1, %2" : "=v"(r) : "v"(lo), "v"(hi)); return r; }

__device__ __forceinline__ void partialSM(f32x16& p0, f32x16& p1, float& m_reg, float& mn, float& alpha, const float C, const float thr) {
  float pmax = p0[0];
#pragma unroll
  for (int r = 1; r < 16; ++r) pmax = fmaxf(pmax, p0[r]);
#pragma unroll
  for (int r = 0; r < 16; ++r) pmax = fmaxf(pmax, p1[r]);
  { auto rr = __builtin_amdgcn_permlane32_swap(__float_as_uint(pmax), __float_as_uint(pmax), false, false);
    pmax = fmaxf(__uint_as_float(rr[0]), __uint_as_float(rr[1])); }
  if (__builtin_expect(__all(pmax - m_reg <= thr), 1)) { mn = m_reg; alpha = 1.f; }
  else { mn = fmaxf(m_reg, pmax); alpha = __builtin_amdgcn_exp2f((m_reg - mn) * C); m_reg = mn; }
  float mnC = -mn * C;
#pragma unroll
  for (int r = 0; r < 16; ++r) p0[r] = fmaf(p0[r], C, mnC);
#pragma unroll
  for (int r = 0; r < 16; ++r) p1[r] = fmaf(p1[r], C, mnC);
#pragma unroll
  for (int r = 0; r < 16; ++r) p0[r] = __builtin_amdgcn_exp2f(p0[r]);
}
__device__ __forceinline__ void finishSM(f32x16& p0, f32x16& p1, float alpha, float& l_reg, bf16x8& pa0, bf16x8& pa1, bf16x8& pa2, bf16x8& pa3) {
#pragma unroll
  for (int r = 0; r < 16; ++r) p1[r] = __builtin_amdgcn_exp2f(p1[r]);
  float ps = 0;
#pragma unroll
  for (int r = 0; r < 16; ++r) ps += p0[r];
#pragma unroll
  for (int r = 0; r < 16; ++r) ps += p1[r];
  { auto rr = __builtin_amdgcn_permlane32_swap(__float_as_uint(ps), __float_as_uint(ps), false, false);
    ps = __uint_as_float(rr[0]) + __uint_as_float(rr[1]); }
  l_reg = l_reg * alpha + ps;
#define PK4(P, BASE, OUT) do { unsigned a0 = cvtpk(P[BASE + 0], P[BASE + 1]), a1 = cvtpk(P[BASE + 2], P[BASE + 3]);   \
    unsigned b0 = cvtpk(P[BASE + 4], P[BASE + 5]), b1 = cvtpk(P[BASE + 6], P[BASE + 7]);                              \
    auto r0 = __builtin_amdgcn_permlane32_swap(a0, b0, false, false); auto r1 = __builtin_amdgcn_permlane32_swap(a1, b1, false, false); \
    u32x4 w = {r0[0], r1[0], r0[1], r1[1]}; OUT = *reinterpret_cast<bf16x8*>(&w); } while (0)
  PK4(p0, 0, pa0); PK4(p0, 8, pa1); PK4(p1, 0, pa2); PK4(p1, 8, pa3);
#undef PK4
}
template <int KS>
__device__ __forceinline__ void qkt(f32x16& p0, f32x16& p1, const bf16_t* Ks, const bf16x8* qr, int r32, int hi) {
  p0 = f32x16{}; p1 = f32x16{};
#pragma unroll
  for (int d0 = 0; d0 < KS; ++d0) { int cb = (d0 * 16 + hi * 8) * 2;
    bf16x8 b0 = *reinterpret_cast<const bf16x8*>((const char*)Ks + KSWZ(r32, cb));
    bf16x8 b1 = *reinterpret_cast<const bf16x8*>((const char*)Ks + KSWZ(32 + r32, cb));
    p0 = __builtin_amdgcn_mfma_f32_32x32x16_bf16(b0, qr[d0], p0, 0, 0, 0);
    p1 = __builtin_amdgcn_mfma_f32_32x32x16_bf16(b1, qr[d0], p1, 0, 0, 0); }
}
__device__ __forceinline__ int v_st(int k, int c) { const int kk = (k & ~0xC) | ((k & 4) << 1) | ((k & 8) >> 1); return ((kk >> 3) * 4 + (c >> 5)) * 512 + ((kk & 7) * 32 + (c & 31)) * 2; }
__device__ __forceinline__ int v_rd_base(int lane) { return ((lane & 3) << 3) | (((lane >> 2) & 3) << 6) | (((lane >> 4) & 1) << 5) | (((lane >> 5) & 1) << 8); }
constexpr int v_rd_off(int d0, int ks, int half) { return d0 * 512 + ks * 4096 + half * 2048; }
template <int OFF> __device__ __forceinline__ s16x4 tr_read(int vb) {
  s16x4 r; asm volatile("ds_read_b64_tr_b16 %0, %1 offset:%2" : "=&v"(r) : "v"(vb), "i"(OFF) : "memory"); return r;
}
template <int D0> __device__ __forceinline__ void pv_one(f32x16& od, int vb, bf16x8 pa0, bf16x8 pa1, bf16x8 pa2, bf16x8 pa3) {
  const s16x4 l0 = tr_read<v_rd_off(D0, 0, 0)>(vb), h0 = tr_read<v_rd_off(D0, 0, 1)>(vb), l1 = tr_read<v_rd_off(D0, 1, 0)>(vb), h1 = tr_read<v_rd_off(D0, 1, 1)>(vb);
  const s16x4 l2 = tr_read<v_rd_off(D0, 2, 0)>(vb), h2 = tr_read<v_rd_off(D0, 2, 1)>(vb), l3 = tr_read<v_rd_off(D0, 3, 0)>(vb), h3 = tr_read<v_rd_off(D0, 3, 1)>(vb);
  asm volatile("s_waitcnt lgkmcnt(0)" ::: "memory"); SBAR();
#define PK(L, H) (bf16x8){L[0], L[1], L[2], L[3], H[0], H[1], H[2], H[3]}
  od = __builtin_amdgcn_mfma_f32_32x32x16_bf16(pa0, PK(l0, h0), od, 0, 0, 0);
  od = __builtin_amdgcn_mfma_f32_32x32x16_bf16(pa1, PK(l1, h1), od, 0, 0, 0);
  od = __builtin_amdgcn_mfma_f32_32x32x16_bf16(pa2, PK(l2, h2), od, 0, 0, 0);
  od = __builtin_amdgcn_mfma_f32_32x32x16_bf16(pa3, PK(l3, h3), od, 0, 0, 0);
#undef PK
}
template <int NOB>
__device__ __forceinline__ void pv_d0(f32x16* o, int vb, bf16x8 pa0, bf16x8 pa1, bf16x8 pa2, bf16x8 pa3) {
  pv_one<0>(o[0], vb, pa0, pa1, pa2, pa3); pv_one<1>(o[1], vb, pa0, pa1, pa2, pa3);
  if constexpr (NOB == 4) { pv_one<2>(o[2], vb, pa0, pa1, pa2, pa3); pv_one<3>(o[3], vb, pa0, pa1, pa2, pa3); }
}

template <int LDQ, int LDK, int LDO, int NOB, int KS>
__device__ __forceinline__ void attn_dense_body(const bf16_t* __restrict__ Qb, const bf16_t* __restrict__ Kh, const bf16_t* __restrict__ Vh,
                                                bf16_t* __restrict__ Ob, int seq, char* lds, const float C, const float thr) {
  int tid_ = threadIdx.x; asm volatile("" : "+v"(tid_));
  const int tid = tid_, wid = tid >> 6, lane = tid & 63, r32 = lane & 31, hi = lane >> 5;
  bf16_t* V_lds = (bf16_t*)lds; bf16_t* K_lds = (bf16_t*)(lds + 2 * SHM_V);
  float* ws = (float*)(lds + 2 * SHM_V + 2 * SHM_K) + wid * 64; float* li_l = ws; float* al_l = ws + 32;
  float m_reg = -1e30f, l_reg = 0; f32x16 o[4] = {}; bf16x8 qr[8];
  const bf16_t* Qw = Qb + (long)(wid * QBLK + r32) * LDQ + hi * 8;
#pragma unroll
  for (int d0 = 0; d0 < KS; ++d0) qr[d0] = *reinterpret_cast<const bf16x8*>(Qw + d0 * 16);
  const int sr = tid >> 4, sc = (tid & 15) * 8, vst0 = v_st(sr, sc), vst1 = v_st(32 + sr, sc);
  const int vb0 = (int)(uintptr_t)V_lds + v_rd_base(lane);
  const bool kact = sc < KS * 16, vact = sc < NOB * 32;
  struct { bf16x8 vs0, vs1, ks0, ks1; } sr_[1];
#define SLOAD(i, k0) do { if (vact) { sr_[i].vs0 = *reinterpret_cast<const bf16x8*>(&Vh[(long)((k0) + sr) * LDK + sc]); sr_[i].vs1 = *reinterpret_cast<const bf16x8*>(&Vh[(long)((k0) + 32 + sr) * LDK + sc]); } \
    if (kact) { sr_[i].ks0 = *reinterpret_cast<const bf16x8*>(&Kh[(long)((k0) + sr) * LDK + sc]); sr_[i].ks1 = *reinterpret_cast<const bf16x8*>(&Kh[(long)((k0) + 32 + sr) * LDK + sc]); } } while (0)
#define SWRITE(b, i) do { if (vact) { *(bf16x8*)((char*)V_lds + (b) * SHM_V + vst0) = sr_[i].vs0;          \
    *(bf16x8*)((char*)V_lds + (b) * SHM_V + vst1) = sr_[i].vs1; } int kc = sc * 2;               \
    if (kact) { *(bf16x8*)((char*)K_lds + (b) * SHM_K + KSWZ(sr, kc)) = sr_[i].ks0;                       \
    *(bf16x8*)((char*)K_lds + (b) * SHM_K + KSWZ(32 + sr, kc)) = sr_[i].ks1; } } while (0)
#define SWAIT() asm volatile("s_waitcnt vmcnt(0)" ::: "memory")
#define RESC(a) do { if (__any((a) < 1.f)) { if (hi == 0) al_l[r32] = (a); asm volatile("s_waitcnt lgkmcnt(0)" ::: "memory"); \
    _Pragma("unroll") for (int d = 0; d < NOB; ++d) _Pragma("unroll") for (int r = 0; r < 16; ++r) o[d][r] *= al_l[crow(r, hi)]; } } while (0)
  f32x16 pA0, pA1, pB0, pB1; float mnA, mnB, alA, alB; bf16x8 pa0, pa1, pa2, pa3; const int NT = seq / KVBLK;
  constexpr int SE = 0, SO = 0;
  if (__builtin_amdgcn_readfirstlane(tid) >= 256) __builtin_amdgcn_s_setprio(1);
  SLOAD(SE, 0); asm volatile("s_waitcnt vmcnt(0)" ::: "memory"); SWRITE(0, SE); __syncthreads();
  qkt<KS>(pA0, pA1, K_lds, qr, r32, hi); partialSM(pA0, pA1, m_reg, mnA, alA, C, thr);
  SLOAD(SO, KVBLK);
  SWAIT(); SWRITE(1, SO); __syncthreads();
  for (int j = 1; j + 1 < NT; j += 2) {
    SBAR(); qkt<KS>(pB0, pB1, (bf16_t*)((char*)K_lds + SHM_K), qr, r32, hi);
    finishSM(pA0, pA1, alA, l_reg, pa0, pa1, pa2, pa3); SBAR();
    SLOAD(SO, (j + 1) * KVBLK); SBAR();
    pv_d0<NOB>(o, vb0, pa0, pa1, pa2, pa3); partialSM(pB0, pB1, m_reg, mnB, alB, C, thr);
    __syncthreads(); SWAIT(); SWRITE(0, SE);
    RESC(alB); __syncthreads();
    SBAR(); qkt<KS>(pA0, pA1, K_lds, qr, r32, hi);
    finishSM(pB0, pB1, alB, l_reg, pa0, pa1, pa2, pa3); SBAR();
    SLOAD(SE, (j + 2) * KVBLK); SBAR();
    pv_d0<NOB>(o, vb0 + (int)SHM_V, pa0, pa1, pa2, pa3); partialSM(pA0, pA1, m_reg, mnA, alA, C, thr);
    __syncthreads(); SWAIT(); SWRITE(1, SO);
    RESC(alA); __syncthreads();
  }
  SBAR(); qkt<KS>(pB0, pB1, (bf16_t*)((char*)K_lds + SHM_K), qr, r32, hi);
  finishSM(pA0, pA1, alA, l_reg, pa0, pa1, pa2, pa3); SBAR();
  pv_d0<NOB>(o, vb0, pa0, pa1, pa2, pa3); partialSM(pB0, pB1, m_reg, mnB, alB, C, thr);
  __syncthreads(); RESC(alB);
  finishSM(pB0, pB1, alB, l_reg, pa0, pa1, pa2, pa3); SBAR();
  pv_d0<NOB>(o, vb0 + (int)SHM_V, pa0, pa1, pa2, pa3);
  __builtin_amdgcn_s_setprio(0);
  int tid2 = threadIdx.x; asm volatile("" : "+v"(tid2));
  const int wid2 = tid2 >> 6, r32e = tid2 & 31, hie = (tid2 >> 5) & 1;
  float* li_e = (float*)(lds + 2 * SHM_V + 2 * SHM_K) + wid2 * 64;
  if (hie == 0) li_e[r32e] = l_reg; asm volatile("s_waitcnt lgkmcnt(0)" ::: "memory");
  float rli[16];
#pragma unroll
  for (int r = 0; r < 16; ++r) rli[r] = __builtin_amdgcn_rcpf(li_e[crow(r, hie)]);
  bf16_t* Ow = Ob + (long)(wid2 * QBLK) * LDO;
#pragma unroll
  for (int r = 0; r < 16; ++r) { int orow = crow(r, hie);
#pragma unroll
    for (int d0 = 0; d0 < NOB; ++d0) { const float v = o[d0][r] * rli[r]; Ow[(long)orow * LDO + d0 * 32 + r32e] = (bf16_t)(cvtpk(v, v) & 0xffffu); } }
#undef SLOAD
#undef SWRITE
#undef SWAIT
#undef RESC
  __syncthreads();
}

template <int LDQ, int LDK, int LDO, int NOB, int KS, int GSH>
__device__ __forceinline__ void attn_phase(const bf16_t* Q, const bf16_t* K, const bf16_t* V, bf16_t* O, bool do_ctx, char* lds, float scale) {
  const float C = scale * 1.4426950408889634f, thr = THR / scale;
  const int G = gridDim.x;
  const int nctx = do_ctx ? 32 : 0, total = nctx + 1024;
  for (int uu = blockIdx.x; uu < total + 0; uu += G) {
      long r0, k0; int h, seq;
      if (uu < nctx) { const int b = uu >> 4; h = uu & 15; r0 = (long)b * RB + SEQ; k0 = r0; seq = CTXL; }
      else { const int u = uu - nctx; const int i = u >> 8, c = u & 255, b = i >> 1, qb = c >> 3; h = (i & 1) * 8 + (c & 7); r0 = (long)b * RB + qb * 256; k0 = (long)b * RB; seq = RB; }
      const int kvh = h >> GSH;
      attn_dense_body<LDQ, LDK, LDO, NOB, KS>(Q + r0 * LDQ + h * 128, K + k0 * LDK + kvh * 128, V + k0 * LDK + kvh * 128, O + r0 * LDO + h * (NOB * 32), seq, lds, C, thr);
  }
}
}

template <int PERM_FFN = 0>
__device__ __forceinline__ void transpose_item(const float* __restrict__ W, int K, int N, bf16_t* __restrict__ WT, LAS float* scr, int item, int lane) {
    const int nblk = N / 32, kb = item / nblk, nb = item - kb * nblk, k0 = 64 * kb, n0 = 32 * nb;
#pragma unroll 8
    for (int i = 0; i < 32; ++i) { const int kk = 2 * i + (lane >> 5); scr[kk * 33 + (lane & 31)] = __builtin_nontemporal_load(W + (size_t)(k0 + kk) * N + n0 + (lane & 31)); }
    asm volatile("s_waitcnt lgkmcnt(0)" ::: "memory");
    const int c = lane & 7;
#pragma unroll
    for (int j = 0; j < 4; ++j) { const int n = (lane >> 3) + 8 * j; const LAS float* s = scr + (8 * c) * 33 + n;
        u32x4 o; o.x = pk2(s[0 * 33], s[1 * 33]); o.y = pk2(s[2 * 33], s[3 * 33]); o.z = pk2(s[4 * 33], s[5 * 33]); o.w = pk2(s[6 * 33], s[7 * 33]);
        int nd = n0 + n; if (PERM_FFN == 1) { const int half = n0 / 3072, chn = n0 - half * 3072; nd = (chn >> 7) * 256 + half * 128 + (chn & 127) + n; }
        if (PERM_FFN == 2 && nd < 3072) { const int d = nd & 127, nb = d >> 6, jj = d & 63; nd = (nd & ~127) + 32 * (jj >> 4) + 8 * ((jj >> 2) & 3) + 4 * nb + (jj & 3); }
        *(u32x4*)(WT + (size_t)nd * K + k0 + 8 * c) = o; }
    asm volatile("s_waitcnt lgkmcnt(0)" ::: "memory");
}
template <int PERM_FFN = 0>
__device__ __forceinline__ void transpose_mat(const float* W, int K, int N, bf16_t* WT, LAS float* scr, int gw, int NGW, int lane) {
    const int items = (K / 64) * (N / 32);
    for (int it = gw; it < items; it += NGW) transpose_item<PERM_FFN>(W, K, N, WT, scr, it, lane);
}

struct Params { const float* in[27]; float* out; unsigned char* ws; };
typedef const Params __attribute__((address_space(4)))* KPtr;
__device__ __forceinline__ KPtr kparams() { KPtr k = (KPtr)__builtin_amdgcn_kernarg_segment_ptr(); asm volatile("" : "+s"(k)); return k; }
#define P_IN(i) (kparams()->in[i])
#define P_WS (kparams()->ws)
#define P_OUT (kparams()->out)

__device__ __forceinline__ void convert_mixer_weights(const Params& p, int layer, LAS float* scr, int gw, int NGW, int lane) {
    const int kind = layer % 3, j = layer / 3;
    bf16_t* WM = (bf16_t*)(P_WS + WS_WM);
    if (kind == 0) {
        transpose_mat<2>(P_IN(12) + (size_t)j * 1024 * 4096, 1024, 4096, WM, scr, gw, NGW, lane);
        transpose_mat(P_IN(15) + (size_t)j * 2048 * 1024, 2048, 1024, WM + (size_t)4096 * 1024, scr, gw, NGW, lane);
    } else if (kind == 1) {
        transpose_mat(P_IN(16) + (size_t)j * 1024 * 5120, 1024, 5120, WM, scr, gw, NGW, lane);
        transpose_mat(P_IN(18) + (size_t)j * 1024 * 1024, 1024, 1024, WM + (size_t)5120 * 1024, scr, gw, NGW, lane);
    } else {
        transpose_mat(P_IN(20) + (size_t)j * 1024 * 1056, 1024, 1056, WM, scr, gw, NGW, lane);
        transpose_mat(P_IN(23) + (size_t)j * 768 * 1536, 768, 1536, WM + (size_t)1280 * 1024, scr, gw, NGW, lane);
        transpose_mat(P_IN(24) + (size_t)j * 256 * 2048, 256, 2048, WM + (size_t)1280 * 1024 + (size_t)1536 * 768, scr, gw, NGW, lane);
        transpose_mat(P_IN(25) + (size_t)j * 1024 * 1024, 1024, 1024, WM + (size_t)1280 * 1024 + (size_t)1536 * 768 + (size_t)2048 * 256, scr, gw, NGW, lane);
    }
}
__device__ __forceinline__ void convert_ffn_weights(const Params& p, int layer, LAS float* scr, int gw, int NGW, int lane) {
    bf16_t* WF = (bf16_t*)(P_WS + WS_WF);
    transpose_mat<1>(P_IN(8) + (size_t)layer * 1024 * 6144, 1024, 6144, WF, scr, gw, NGW, lane);
    transpose_mat(P_IN(11) + (size_t)layer * 3072 * 1024, 3072, 1024, WF + (size_t)6144 * 1024, scr, gw, NGW, lane);
}

__device__ __forceinline__ void adaln_phase(const Params& p, LAS float* ldsf, int tid, int l_lo, int l_hi, int blk, int nblk) {
    LAS float* sc = ldsf; LAS float* red = ldsf + 3072;
    const float* c = P_IN(1); const float* cc = P_IN(3); const float* w_ada = P_IN(4); const float* b_ada = P_IN(5);
    float* mod = (float*)(P_WS + WS_MOD);
    __syncthreads();
    for (int i = tid; i < 3072; i += NTHREADS) { const int slot = i >> 10, k = i & 1023; const float v = slot < 2 ? c[slot * 1024 + k] : cc[k]; sc[i] = silu_f(v); }
    __syncthreads();
    for (int item = blk; item < (l_hi - l_lo) * 192; item += nblk) {
        const int lq = item / 192, l = l_lo + lq, n0 = (item - lq * 192) * 32, kp = tid >> 5, nn = tid & 31;
        const float* w = w_ada + ((size_t)l * 1024 + kp * 64) * 6144 + n0 + nn;
        float a0 = 0.f, a1 = 0.f, a2 = 0.f;
#pragma unroll 16
        for (int k = 0; k < 64; ++k) { const float wv = __builtin_nontemporal_load(w + (size_t)k * 6144); a0 += sc[kp * 64 + k] * wv; a1 += sc[1024 + kp * 64 + k] * wv; a2 += sc[2048 + kp * 64 + k] * wv; }
        red[(kp * 3 + 0) * 32 + nn] = a0; red[(kp * 3 + 1) * 32 + nn] = a1; red[(kp * 3 + 2) * 32 + nn] = a2;
        __syncthreads();
        if (tid < 96) { const int slot = tid >> 5; float s = b_ada[l * 6144 + n0 + nn];
            for (int q = 0; q < 16; ++q) s += red[(q * 3 + slot) * 32 + nn];
            mod[((size_t)l * 3 + slot) * 6144 + n0 + nn] = s; }
        __syncthreads();
    }
}
__device__ __forceinline__ void tables_phase(const Params& p, int tid) {
    float* lb = (float*)(P_WS + WS_LB); float* TA = (float*)(P_WS + WS_TA); float* TMt = (float*)(P_WS + WS_TM);
    const float* lbs = P_IN(19);
    if (blockIdx.x == gridDim.x - 1) {
        for (int ch = tid; ch < 1024; ch += NTHREADS) { const float l0 = lbs[ch], l1 = lbs[1024 + ch], l2 = lbs[2048 + ch], l3 = lbs[3072 + ch];
            const float mx = fmaxf(fmaxf(l0, l1), fmaxf(l2, l3)); const float e0 = expf(l0 - mx), e1 = expf(l1 - mx), e2 = expf(l2 - mx), e3 = expf(l3 - mx);
            lb[ch] = e1 / (e0 + e1 + e2 + e3); }
    }
    if (blockIdx.x == gridDim.x - 2 || gridDim.x < 2) {
        for (int i = tid; i < 128 * 32; i += NTHREADS) { const int pos = i >> 5, j = i & 31; const float inv = powf(10000.f, -(float)(2 * j) / 64.f); const float ang = (float)pos * inv;
            TA[2 * i] = cosf(ang); TA[2 * i + 1] = sinf(ang); }
        for (int i = tid; i < 128 * 8; i += NTHREADS) { const int pos = i >> 3, j = i & 7; const float inv = powf(10000.f, -(float)(2 * j) / 16.f); const float ang = (float)pos * inv;
            TMt[2 * i] = cosf(ang); TMt[2 * i + 1] = sinf(ang); }
    }
}

template <bool LATENT_ONLY, bool XNF = false>
__device__ __forceinline__ void prenorm_phase(const float* xlat, const float* xctx, const float* gain, const float* modl, int ci, bf16_t* XN, int gw, int NGW, int lane) {
    for (int r0 = gw; r0 < M; r0 += 2 * NGW) {
        f32x4 v[2][4]; const float* md[2]; bool ok[2]; int rr[2];
#pragma unroll
        for (int u = 0; u < 2; ++u) { const int r = r0 + u * NGW; const int b = r / RB, t = r - b * RB; rr[u] = XNF ? xnf_row(b, t) : r;
            ok[u] = (r < M) && !(LATENT_ONLY && t >= SEQ);
            const float* xr = t < SEQ ? xlat + ((size_t)b * SEQ + t) * D : xctx + ((size_t)b * CTXL + (t - SEQ)) * D;
            md[u] = modl + (t < SEQ ? b : 2) * 6144 + ci * 1024;
            if (ok[u]) {
#pragma unroll
                for (int j = 0; j < 4; ++j) v[u][j] = *(const f32x4*)(xr + j * 256 + lane * 4); } }
#pragma unroll
        for (int u = 0; u < 2; ++u) { if (!ok[u]) continue;
            float s = 0.f;
#pragma unroll
            for (int j = 0; j < 4; ++j) s += (v[u][j].x * v[u][j].x + v[u][j].y * v[u][j].y) + (v[u][j].z * v[u][j].z + v[u][j].w * v[u][j].w);
            const float rs = rsqrtf(wave_sum(s) * (1.f / D) + EPS);
#pragma unroll
            for (int j = 0; j < 4; ++j) { const int c = j * 256 + lane * 4; const f32x4 g = *(const f32x4*)(gain + c), sh = *(const f32x4*)(md[u] + c), sc = *(const f32x4*)(md[u] + 1024 + c);
                const f32x4 y = (v[u][j] * rs) * g * (1.f + sc) + sh; u32x2 w; w.x = pk2(y.x, y.y); w.y = pk2(y.z, y.w);
                *(u32x2*)(XN + (size_t)rr[u] * D + c) = w; } }
    }
}
__device__ __forceinline__ void gqa_qknorm_phase(bf16_t* P, const float* qg, const float* kg, const float* TA, int gw, int NGW, int lane) {
    const int sl = lane >> 4, dd = (lane & 15) * 4;
    for (int r = gw; r < M; r += NGW) {
        const int b = r / RB, t = r - b * RB; const bool lat = t < SEQ; const int ri = t >> 6, ci = t & 63;
        bf16_t* pr = P + (size_t)r * 4096;
        u32x2 la[6], lb2[6];
#pragma unroll
        for (int it = 0; it < 6; ++it) { const bf16_t* pp = pr + (it * 4 + sl) * 128 + dd; la[it] = *(const u32x2*)pp; lb2[it] = *(const u32x2*)(pp + 64); }
#pragma unroll
        for (int it = 0; it < 6; ++it) { const int slot = it * 4 + sl; bf16_t* pp = pr + slot * 128 + dd;
            const u32x2 a = la[it], bb = lb2[it];
            float x1[4] = {bflo(a.x), bfhi(a.x), bflo(a.y), bfhi(a.y)}, x2[4] = {bflo(bb.x), bfhi(bb.x), bflo(bb.y), bfhi(bb.y)};
            float ss = 0.f;
#pragma unroll
            for (int e = 0; e < 4; ++e) ss += x1[e] * x1[e] + x2[e] * x2[e];
            const float rs = rsqrtf(sum16(ss) * (1.f / 128.f) + EPS);
            const float* gn = slot < 16 ? qg : kg; const f32x4 g1 = *(const f32x4*)(gn + dd), g2 = *(const f32x4*)(gn + 64 + dd);
            float o1[4], o2[4];
#pragma unroll
            for (int e = 0; e < 4; ++e) { const float y1 = x1[e] * rs * g1[e], y2 = x2[e] * rs * g2[e];
                if (lat) { const int jj = dd + e; const int pos = jj < 32 ? ri : ci; const f32x2 cs = *(const f32x2*)(TA + (pos * 32 + (jj & 31)) * 2);
                    o1[e] = y1 * cs.x - y2 * cs.y; o2[e] = y1 * cs.y + y2 * cs.x; }
                else { o1[e] = y1; o2[e] = y2; } }
            u32x2 w1, w2; w1.x = pk2(o1[0], o1[1]); w1.y = pk2(o1[2], o1[3]); w2.x = pk2(o2[0], o2[1]); w2.y = pk2(o2[2], o2[3]);
            *(u32x2*)pp = w1; *(u32x2*)(pp + 64) = w2; }
    }
}
__device__ __forceinline__ void mla_norm_phase(const bf16_t* P1, const float* qg, const float* kvg, const float* TMt, bf16_t* CQ, bf16_t* CKV, bf16_t* Qp, bf16_t* Kp, bf16_t* Vp, int gw, int NGW, int lane) {
    for (int r = gw; r < M; r += NGW) {
        const int b = r / RB, t = r - b * RB; const bool lat = t < SEQ; const int ri = t >> 6, ci = t & 63;
        const bf16_t* pr = P1 + (size_t)r * 1280;
        float x[12]; float ss = 0.f;
#pragma unroll
        for (int j = 0; j < 3; ++j) { const u32x2 w = *(const u32x2*)(pr + j * 256 + lane * 4); x[4 * j] = bflo(w.x); x[4 * j + 1] = bfhi(w.x); x[4 * j + 2] = bflo(w.y); x[4 * j + 3] = bfhi(w.y); }
#pragma unroll
        for (int e = 0; e < 12; ++e) ss += x[e] * x[e];
        const float rs = rsqrtf(wave_sum(ss) * (1.f / 768.f) + EPS);
#pragma unroll
        for (int j = 0; j < 3; ++j) { const int c = j * 256 + lane * 4; const f32x4 g = *(const f32x4*)(qg + c);
            u32x2 w; w.x = pk2(x[4 * j] * rs * g.x, x[4 * j + 1] * rs * g.y); w.y = pk2(x[4 * j + 2] * rs * g.z, x[4 * j + 3] * rs * g.w);
            *(u32x2*)(CQ + (size_t)r * 768 + c) = w; }
        { const u32x2 w = *(const u32x2*)(pr + 768 + lane * 4); const float y0 = bflo(w.x), y1 = bfhi(w.x), y2 = bflo(w.y), y3 = bfhi(w.y);
          const float rs2 = rsqrtf(wave_sum(y0 * y0 + y1 * y1 + y2 * y2 + y3 * y3) * (1.f / 256.f) + EPS); const f32x4 g = *(const f32x4*)(kvg + lane * 4);
          u32x2 o; o.x = pk2(y0 * rs2 * g.x, y1 * rs2 * g.y); o.y = pk2(y2 * rs2 * g.z, y3 * rs2 * g.w);
          *(u32x2*)(CKV + (size_t)r * 256 + lane * 4) = o; }
        { const float xr = bf2f(pr[1024 + (lane & 31)]); const float pa = __shfl_xor(xr, 16); float out = xr;
          if (lat) { const int jj = lane & 15; const int pos = jj < 8 ? ri : ci; const f32x2 cs = *(const f32x2*)(TMt + (pos * 8 + (jj & 7)) * 2);
              out = ((lane & 16) == 0) ? (xr * cs.x - pa * cs.y) : (pa * cs.y + xr * cs.x); }
          const bf16_t ob = (bf16_t)(pk2(out, out) & 0xffffu);
          if (lane < 32) {
#pragma unroll
              for (int h = 0; h < 16; ++h) Kp[(size_t)r * 2048 + h * 128 + 64 + lane] = ob; } }
    }
}
template <bool LATENT_ONLY>
__device__ __forceinline__ void convgate_phase(const bf16_t* U, const float* cw, const float* cb, bf16_t* Gb, int gtid, int NT) {
    const int total = (M / 8) * 384;
    for (int idx = gtid; idx < total; idx += NT) {
        const int strip = idx / 384, cgi = idx - strip * 384, c0 = cgi * 8, r0 = strip * 8, t0 = r0 % RB;
        if (LATENT_ONLY && t0 >= SEQ) continue;
        const bool hasprev = (t0 != 0 && t0 != SEQ), hasnext = (t0 + 8 != SEQ && t0 + 8 != RB);
        float wa[3][8], wv[3][8], ba[8], bv[8];
#pragma unroll
        for (int j = 0; j < 3; ++j)
#pragma unroll
            for (int q = 0; q < 2; ++q) { const f32x4 a = *(const f32x4*)(cw + j * 6144 + c0 + 4 * q), v = *(const f32x4*)(cw + j * 6144 + 3072 + c0 + 4 * q);
#pragma unroll
                for (int e = 0; e < 4; ++e) { wa[j][4 * q + e] = a[e]; wv[j][4 * q + e] = v[e]; } }
#pragma unroll
        for (int q = 0; q < 2; ++q) { const f32x4 a = *(const f32x4*)(cb + c0 + 4 * q), v = *(const f32x4*)(cb + 3072 + c0 + 4 * q);
#pragma unroll
            for (int e = 0; e < 4; ++e) { ba[4 * q + e] = a[e]; bv[4 * q + e] = v[e]; } }
        const u32x4 z = {0u, 0u, 0u, 0u};
        u32x4 ra[10], rv[10];
#pragma unroll
        for (int i = 0; i < 10; ++i) { const bool ok = (i == 0) ? hasprev : ((i == 9) ? hasnext : true);
            if (ok) { ra[i] = *(const u32x4*)(U + (size_t)(r0 - 1 + i) * 6144 + c0); rv[i] = *(const u32x4*)(U + (size_t)(r0 - 1 + i) * 6144 + 3072 + c0); } else { ra[i] = z; rv[i] = z; } }
#pragma unroll
        for (int i = 0; i < 8; ++i) {
            const u32x4 pa = ra[i], ca = ra[i + 1], na = ra[i + 2], pv = rv[i], cv = rv[i + 1], nv = rv[i + 2];
            float g[8];
#pragma unroll
            for (int q = 0; q < 4; ++q) {
                const float a_lo = ba[2 * q] + wa[0][2 * q] * bflo(pa[q]) + wa[1][2 * q] * bflo(ca[q]) + wa[2][2 * q] * bflo(na[q]);
                const float a_hi = ba[2 * q + 1] + wa[0][2 * q + 1] * bfhi(pa[q]) + wa[1][2 * q + 1] * bfhi(ca[q]) + wa[2][2 * q + 1] * bfhi(na[q]);
                const float v_lo = bv[2 * q] + wv[0][2 * q] * bflo(pv[q]) + wv[1][2 * q] * bflo(cv[q]) + wv[2][2 * q] * bflo(nv[q]);
                const float v_hi = bv[2 * q + 1] + wv[0][2 * q + 1] * bfhi(pv[q]) + wv[1][2 * q + 1] * bfhi(cv[q]) + wv[2][2 * q + 1] * bfhi(nv[q]);
                g[2 * q] = silu_f(a_lo) * v_lo; g[2 * q + 1] = silu_f(a_hi) * v_hi; }
            u32x4 o; o.x = pk2(g[0], g[1]); o.y = pk2(g[2], g[3]); o.z = pk2(g[4], g[5]); o.w = pk2(g[6], g[7]);
            *(u32x4*)(Gb + (size_t)(r0 + i) * DFF + c0) = o;
        }
    }
}
__device__ __forceinline__ void final_norm_phase(float* xlat, const float* gain, int gw, int NGW, int lane) {
    for (int r = gw; r < 2 * SEQ; r += NGW) {
        float* xr = xlat + (size_t)r * D; f32x4 v[4]; float s = 0.f;
#pragma unroll
        for (int j = 0; j < 4; ++j) { v[j] = *(const f32x4*)(xr + j * 256 + lane * 4); s += (v[j].x * v[j].x + v[j].y * v[j].y) + (v[j].z * v[j].z + v[j].w * v[j].w); }
        const float rs = rsqrtf(wave_sum(s) * (1.f / D) + EPS);
#pragma unroll
        for (int j = 0; j < 4; ++j) { const int c = j * 256 + lane * 4; const f32x4 g = *(const f32x4*)(gain + c); *(f32x4*)(xr + c) = (v[j] * rs) * g; }
    }
}

constexpr int NSEG = 8, SEGLEN = 1056, TB = 16, NBATCH = SEGLEN / TB;
__device__ __forceinline__ int hgrn_row(int b, int dir, int tau) {
    if (tau < CTXL) { const int tc = dir ? (CTXL - 1 - tau) : tau; return b * RB + SEQ + tc; }
    const int tt = tau - CTXL; const int t = dir ? (SEQ - 1 - tt) : tt; return b * RB + t;
}
template <bool OUT>
__device__ __forceinline__ void hgrn_scan_item(int item, const bf16_t* __restrict__ P, const float* __restrict__ lbv, float* Lst, float* Dst, bf16_t* Odir, char* lds, int tid) {
    const int seg = item % NSEG, bdh = item / NSEG, h = bdh & 7, dir = (bdh >> 3) & 1, b = bdh >> 4;
    const int wave = tid >> 6, lane = tid & 63;
    float* Fs = (float*)lds; float* Qs = Fs + TB * 128; float* Vs = Qs + TB * 128; float* Ob = Vs + TB * 128;
    f32x2 S[16];
#pragma unroll
    for (int j = 0; j < 16; ++j) S[j] = (f32x2){0.f, 0.f};
    if (OUT) {
        for (int sj = 0; sj < seg; ++sj) { const float* Lj = Lst + (size_t)(bdh * NSEG + sj) * 16384; const float* Dj = Dst + (size_t)(bdh * NSEG + sj) * 128;
#pragma unroll
            for (int j = 0; j < 16; ++j) { const int dk = wave * 16 + j; const float d = Dj[dk]; const f32x2 l2 = *(const f32x2*)(Lj + dk * 128 + 2 * lane); S[j] = S[j] * d + l2; } }
    }
    float Dacc[16];
#pragma unroll
    for (int j = 0; j < 16; ++j) Dacc[j] = 1.f;
    const int ls = tid >> 5, ld0 = (tid & 31) * 4;
    const f32x4 lb4 = *(const f32x4*)(lbv + h * 128 + ld0);
    const int fcol = dir ? 3072 : 2048;
    const float qscale = 0.08838834764831845f;
    u32x2 rf, rq, rv;
    { const int r = hgrn_row(b, dir, seg * SEGLEN + ls); const bf16_t* pp = P + (size_t)r * 5120 + h * 128 + ld0;
      rq = *(const u32x2*)pp; rv = *(const u32x2*)(pp + 1024); rf = *(const u32x2*)(pp + fcol); }
    for (int bi = 0; bi < NBATCH; ++bi) {
        { f32x4 f4, q4, v4;
          f4.x = lb4.x + (1.f - lb4.x) * sigmoid_f(bflo(rf.x)); f4.y = lb4.y + (1.f - lb4.y) * sigmoid_f(bfhi(rf.x));
          f4.z = lb4.z + (1.f - lb4.z) * sigmoid_f(bflo(rf.y)); f4.w = lb4.w + (1.f - lb4.w) * sigmoid_f(bfhi(rf.y));
          q4.x = bflo(rq.x) * qscale; q4.y = bfhi(rq.x) * qscale; q4.z = bflo(rq.y) * qscale; q4.w = bfhi(rq.y) * qscale;
          v4.x = bflo(rv.x); v4.y = bfhi(rv.x); v4.z = bflo(rv.y); v4.w = bfhi(rv.y);
          *(f32x4*)(Fs + ls * 128 + ld0) = f4; *(f32x4*)(Qs + ls * 128 + ld0) = q4; *(f32x4*)(Vs + ls * 128 + ld0) = v4; }
        if (bi + 1 < NBATCH) { const int r = hgrn_row(b, dir, seg * SEGLEN + (bi + 1) * TB + ls); const bf16_t* pp = P + (size_t)r * 5120 + h * 128 + ld0;
            rq = *(const u32x2*)pp; rv = *(const u32x2*)(pp + 1024); rf = *(const u32x2*)(pp + fcol); }
        __syncthreads();
#pragma unroll 2
        for (int s = 0; s < TB; ++s) {
            f32x4 fa[4], qa[4];
#pragma unroll
            for (int k = 0; k < 4; ++k) { fa[k] = *(const f32x4*)(Fs + s * 128 + wave * 16 + 4 * k); if (OUT) qa[k] = *(const f32x4*)(Qs + s * 128 + wave * 16 + 4 * k); }
            const f32x2 v2 = *(const f32x2*)(Vs + s * 128 + 2 * lane);
            f32x2 o0 = (f32x2){0.f, 0.f}, o1 = o0, o2 = o0, o3 = o0;
#pragma unroll
            for (int j = 0; j < 16; j += 4) {
#pragma unroll
                for (int e = 0; e < 4; ++e) { const float f = fa[j >> 2][e]; const f32x2 tdiff = S[j + e] - v2; S[j + e] = tdiff * f + v2; if (!OUT) Dacc[j + e] *= f; }
                if (OUT) { const f32x4 q4 = qa[j >> 2]; o0 += S[j] * q4[0]; o1 += S[j + 1] * q4[1]; o2 += S[j + 2] * q4[2]; o3 += S[j + 3] * q4[3]; }
            }
            if (OUT) *(f32x2*)(Ob + (size_t)(wave * TB + s) * 128 + 2 * lane) = (o0 + o1) + (o2 + o3);
        }
        __syncthreads();
        if (OUT) { f32x4 acc = *(const f32x4*)(Ob + (size_t)ls * 128 + ld0);
#pragma unroll
            for (int w = 1; w < 8; ++w) acc += *(const f32x4*)(Ob + (size_t)(w * TB + ls) * 128 + ld0);
            const int r = hgrn_row(b, dir, seg * SEGLEN + bi * TB + ls); u32x2 w2; w2.x = pk2(acc.x, acc.y); w2.y = pk2(acc.z, acc.w);
            *(u32x2*)(Odir + ((size_t)dir * M + r) * 1024 + h * 128 + ld0) = w2; }
    }
    if (!OUT) { float* Lj = Lst + (size_t)(bdh * NSEG + seg) * 16384; float* Dj = Dst + (size_t)(bdh * NSEG + seg) * 128;
#pragma unroll
        for (int j = 0; j < 16; ++j) { const int dk = wave * 16 + j; *(f32x2*)(Lj + dk * 128 + 2 * lane) = S[j]; if (lane == 0) Dj[dk] = Dacc[j]; } }
    __syncthreads();
}
__device__ __forceinline__ void hgrn_state_item(int item, const bf16_t* __restrict__ P, const float* __restrict__ lbv, float* Lst, float* Dst, char* lds, int tid) {
    const int seg = item % NSEG, bdh = item / NSEG, h = bdh & 7, dir = (bdh >> 3) & 1, b = bdh >> 4;
    const int wave = tid >> 6, lane = tid & 63, r32 = lane & 31, hi = lane >> 5;
    float* LfS = (float*)lds; float* KfS = LfS + 2048;
    bf16_t* Ka = (bf16_t*)(KfS + 2048); bf16_t* Vb = Ka + 2 * 2048;
    const int ls = tid >> 5, ld0 = (tid & 31) * 4;
    const f32x4 lb4 = *(const f32x4*)(lbv + h * 128 + ld0);
    const int fcol = dir ? 3072 : 2048;
    const int mt = wave >> 1, nt0 = (wave & 1) * 2;
    f32x16 acc0 = {}, acc1 = {};
    float carry = 0.f;
    u32x2 rf, rv;
    { const int r = hgrn_row(b, dir, seg * SEGLEN + (NBATCH - 1) * TB + ls); const bf16_t* pp = P + (size_t)r * 5120 + h * 128 + ld0;
      rv = *(const u32x2*)(pp + 1024); rf = *(const u32x2*)(pp + fcol); }
    for (int jb = NBATCH - 1; jb >= 0; --jb) {
        const int buf = jb & 1;
        { f32x4 f4, lf, kf;
          f4.x = lb4.x + (1.f - lb4.x) * sigmoid_f(bflo(rf.x)); f4.y = lb4.y + (1.f - lb4.y) * sigmoid_f(bfhi(rf.x));
          f4.z = lb4.z + (1.f - lb4.z) * sigmoid_f(bflo(rf.y)); f4.w = lb4.w + (1.f - lb4.w) * sigmoid_f(bfhi(rf.y));
#pragma unroll
          for (int e = 0; e < 4; ++e) { lf[e] = __logf(f4[e]); kf[e] = 1.f - f4[e]; }
          *(f32x4*)(LfS + ls * 128 + ld0) = lf; *(f32x4*)(KfS + ls * 128 + ld0) = kf;
          bf16_t* vb = Vb + buf * 2048 + ld0 * 16 + ls;
          vb[0] = (bf16_t)(rv.x & 0xffffu); vb[16] = (bf16_t)(rv.x >> 16); vb[32] = (bf16_t)(rv.y & 0xffffu); vb[48] = (bf16_t)(rv.y >> 16); }
        if (jb > 0) { const int r = hgrn_row(b, dir, seg * SEGLEN + (jb - 1) * TB + ls); const bf16_t* pp = P + (size_t)r * 5120 + h * 128 + ld0;
            rv = *(const u32x2*)(pp + 1024); rf = *(const u32x2*)(pp + fcol); }
        __syncthreads();
        { const int sd = tid & 127, sg = tid >> 7; float lfv[16];
#pragma unroll
          for (int q = 0; q < 16; ++q) lfv[q] = LfS[q * 128 + sd];
          float tot = 0.f, c = carry;
#pragma unroll
          for (int q = 0; q < 16; ++q) { tot += lfv[q]; if (q > 4 * sg + 3) c += lfv[q]; }
          float kh[4];
#pragma unroll
          for (int e = 3; e >= 0; --e) { const int st = 4 * sg + e; kh[e] = KfS[st * 128 + sd] * __expf(c); c += LfS[st * 128 + sd]; }
          carry += tot;
          u32x2 w; w.x = pk2(kh[0], kh[1]); w.y = pk2(kh[2], kh[3]); *(u32x2*)(Ka + buf * 2048 + sd * 16 + 4 * sg) = w; }
        __syncthreads();
        { const bf16x8 a = *(const bf16x8*)(Ka + buf * 2048 + (mt * 32 + r32) * 16 + hi * 8);
          const bf16x8 b0 = *(const bf16x8*)(Vb + buf * 2048 + (nt0 * 32 + r32) * 16 + hi * 8), b1 = *(const bf16x8*)(Vb + buf * 2048 + ((nt0 + 1) * 32 + r32) * 16 + hi * 8);
          acc0 = __builtin_amdgcn_mfma_f32_32x32x16_bf16(a, b0, acc0, 0, 0, 0); acc1 = __builtin_amdgcn_mfma_f32_32x32x16_bf16(a, b1, acc1, 0, 0, 0); }
    }
    float* Lj = Lst + (size_t)item * 16384;
#pragma unroll
    for (int r = 0; r < 16; ++r) { const int row = mt * 32 + (r & 3) + 8 * (r >> 2) + 4 * hi; Lj[row * 128 + nt0 * 32 + r32] = acc0[r]; Lj[row * 128 + (nt0 + 1) * 32 + r32] = acc1[r]; }
    if (tid < 128) Dst[(size_t)item * 128 + tid] = __expf(carry);
    __syncthreads();
}
#define SWZ16(row, colB) ((row) * 256 + ((colB) ^ (((row) & 15) << 4)))
__device__ __forceinline__ void hgrn_out_item(int item, const bf16_t* __restrict__ P, const float* __restrict__ lbv, const float* Lst, const float* Dst, bf16_t* Odir, char* lds, int tid) {
    const int seg = item % NSEG, bdh = item / NSEG, h = bdh & 7, dir = (bdh >> 3) & 1, b = bdh >> 4;
    const int wave = __builtin_amdgcn_readfirstlane(tid >> 6), lane = tid & 63, r32 = lane & 31, hi = lane >> 5;
    float* LfS = (float*)lds; float* KfS = (float*)(lds + 8192); float* QfS = (float*)(lds + 16384); float* Part = (float*)(lds + 24576); float* Ec = (float*)(lds + 26624);
    char* Qt = lds + 28672; char* Kt = lds + 36864; bf16_t* Ka = (bf16_t*)(lds + 45056); bf16_t* Am = (bf16_t*)(lds + 49152); bf16_t* Vb = (bf16_t*)(lds + 50176); char* Sb = lds + 58368;
    const int ls = tid >> 5, ld0 = (tid & 31) * 4;
    const f32x4 lb4 = *(const f32x4*)(lbv + h * 128 + ld0);
    const int fcol = dir ? 3072 : 2048;
    const float qscale = 0.08838834764831845f;
    const int mt = wave >> 1, nt0 = (wave & 1) * 2;
    { const u32x4 z = {0u, 0u, 0u, 0u};
      for (int i = tid; i < 256; i += NTHREADS) { *(u32x4*)(Qt + 4096 + i * 16) = z; *(u32x4*)(Kt + 4096 + i * 16) = z; }
      if (tid < 32) *(u32x4*)((char*)Am + 512 + tid * 16) = z; }
    f32x16 acc0 = {}, acc1 = {};
    for (int sj = 0; sj < seg; ++sj) { const float* Lj = Lst + (size_t)(bdh * NSEG + sj) * 16384; const float* Dj = Dst + (size_t)(bdh * NSEG + sj) * 128;
#pragma unroll
        for (int r = 0; r < 16; ++r) { const int d = mt * 32 + (r & 3) + 8 * (r >> 2) + 4 * hi; const float dd = Dj[d];
            acc0[r] = acc0[r] * dd + Lj[d * 128 + nt0 * 32 + r32]; acc1[r] = acc1[r] * dd + Lj[d * 128 + (nt0 + 1) * 32 + r32]; } }
#define HG_WRITE_SB() do { _Pragma("unroll") for (int q = 0; q < 4; ++q) { const int colB = 2 * (mt * 32 + 8 * q + 4 * hi); \
        u32x2 w0; w0.x = pk2(acc0[4 * q], acc0[4 * q + 1]); w0.y = pk2(acc0[4 * q + 2], acc0[4 * q + 3]); \
        u32x2 w1; w1.x = pk2(acc1[4 * q], acc1[4 * q + 1]); w1.y = pk2(acc1[4 * q + 2], acc1[4 * q + 3]); \
        *(u32x2*)(Sb + SWZ16(nt0 * 32 + r32, colB)) = w0; *(u32x2*)(Sb + SWZ16((nt0 + 1) * 32 + r32, colB)) = w1; } } while (0)
    HG_WRITE_SB();
    u32x2 rf, rq, rv;
#define HG_GLOAD(c) do { const int r_ = hgrn_row(b, dir, seg * SEGLEN + (c) * TB + ls); const bf16_t* pp_ = P + (size_t)r_ * 5120 + h * 128 + ld0; \
        rq = *(const u32x2*)pp_; rv = *(const u32x2*)(pp_ + 1024); rf = *(const u32x2*)(pp_ + fcol); } while (0)
#define HG_STAGE(c) do { f32x4 f4, lf, kf, q4; \
        f4.x = lb4.x + (1.f - lb4.x) * sigmoid_f(bflo(rf.x)); f4.y = lb4.y + (1.f - lb4.y) * sigmoid_f(bfhi(rf.x)); \
        f4.z = lb4.z + (1.f - lb4.z) * sigmoid_f(bflo(rf.y)); f4.w = lb4.w + (1.f - lb4.w) * sigmoid_f(bfhi(rf.y)); \
        _Pragma("unroll") for (int e = 0; e < 4; ++e) { lf[e] = __logf(f4[e]); kf[e] = 1.f - f4[e]; } \
        q4.x = bflo(rq.x) * qscale; q4.y = bfhi(rq.x) * qscale; q4.z = bflo(rq.y) * qscale; q4.w = bfhi(rq.y) * qscale; \
        *(f32x4*)(LfS + ls * 128 + ld0) = lf; *(f32x4*)(KfS + ls * 128 + ld0) = kf; *(f32x4*)(QfS + ls * 128 + ld0) = q4; \
        bf16_t* vb_ = Vb + ((c) & 1) * 2048 + ld0 * 16 + ls; \
        vb_[0] = (bf16_t)(rv.x & 0xffffu); vb_[16] = (bf16_t)(rv.x >> 16); vb_[32] = (bf16_t)(rv.y & 0xffffu); vb_[48] = (bf16_t)(rv.y >> 16); } while (0)
    HG_GLOAD(0); HG_STAGE(0); HG_GLOAD(1);
    __syncthreads();
    const int sd = tid & 127, sg = tid >> 7;
    for (int c = 0; c < NBATCH; ++c) {
        { float lfv[16];
#pragma unroll
          for (int q = 0; q < 16; ++q) lfv[q] = LfS[q * 128 + sd];
          float tot = 0.f, bb = 0.f;
#pragma unroll
          for (int q = 0; q < 16; ++q) { tot += lfv[q]; if (q < 4 * sg) bb += lfv[q]; }
          float kh[4];
#pragma unroll
          for (int e = 0; e < 4; ++e) { const int st = 4 * sg + e; bb += LfS[st * 128 + sd]; const float kk = KfS[st * 128 + sd], qq = QfS[st * 128 + sd];
              const float qt = qq * __expf(bb), kt = kk * __expf(fminf(-bb, 80.f)); kh[e] = kk * __expf(tot - bb);
              *(bf16_t*)(Qt + SWZ16(st, 2 * sd)) = (bf16_t)(pk2(qt, qt) & 0xffffu); *(bf16_t*)(Kt + SWZ16(st, 2 * sd)) = (bf16_t)(pk2(kt, kt) & 0xffffu); }
          u32x2 w; w.x = pk2(kh[0], kh[1]); w.y = pk2(kh[2], kh[3]); *(u32x2*)(Ka + sd * 16 + 4 * sg) = w;
          if (sg == 0) Ec[sd] = __expf(tot); }
        __syncthreads();
        f32x16 oacc = {};
        if (wave < 4) {
#pragma unroll
            for (int kd = 0; kd < 8; ++kd) { const int colB = (16 * kd + 8 * hi) * 2;
                const bf16x8 a = *(const bf16x8*)(Qt + SWZ16(r32, colB)), bq = *(const bf16x8*)(Sb + SWZ16(wave * 32 + r32, colB));
                oacc = __builtin_amdgcn_mfma_f32_32x32x16_bf16(a, bq, oacc, 0, 0, 0); }
        } else if (wave == 4) {
            f32x16 am = {};
#pragma unroll
            for (int kd = 0; kd < 8; ++kd) { const int colB = (16 * kd + 8 * hi) * 2;
                const bf16x8 a = *(const bf16x8*)(Qt + SWZ16(r32, colB)), bq = *(const bf16x8*)(Kt + SWZ16(r32, colB));
                am = __builtin_amdgcn_mfma_f32_32x32x16_bf16(a, bq, am, 0, 0, 0); }
            if (r32 < 16) {
#pragma unroll
                for (int r = 0; r < 8; ++r) { const int t = (r & 3) + 8 * (r >> 2) + 4 * hi; const float v = (r32 <= t) ? am[r] : 0.f; Am[t * 16 + r32] = (bf16_t)(pk2(v, v) & 0xffffu); } }
        }
        {
#pragma unroll
          for (int r = 0; r < 16; ++r) { const float e = Ec[mt * 32 + (r & 3) + 8 * (r >> 2) + 4 * hi]; acc0[r] *= e; acc1[r] *= e; }
          const bf16_t* vbc = Vb + (c & 1) * 2048;
          const bf16x8 a = *(const bf16x8*)(Ka + (mt * 32 + r32) * 16 + hi * 8);
          const bf16x8 b0 = *(const bf16x8*)(vbc + (nt0 * 32 + r32) * 16 + hi * 8), b1 = *(const bf16x8*)(vbc + ((nt0 + 1) * 32 + r32) * 16 + hi * 8);
          acc0 = __builtin_amdgcn_mfma_f32_32x32x16_bf16(a, b0, acc0, 0, 0, 0); acc1 = __builtin_amdgcn_mfma_f32_32x32x16_bf16(a, b1, acc1, 0, 0, 0); }
        __syncthreads();
        if (wave < 4) { const bf16_t* vbc = Vb + (c & 1) * 2048;
            const bf16x8 a = *(const bf16x8*)(Am + r32 * 16 + hi * 8), bq = *(const bf16x8*)(vbc + (wave * 32 + r32) * 16 + hi * 8);
            oacc = __builtin_amdgcn_mfma_f32_32x32x16_bf16(a, bq, oacc, 0, 0, 0);
#pragma unroll
            for (int r = 0; r < 8; ++r) { const int t = (r & 3) + 8 * (r >> 2) + 4 * hi; const int row = hgrn_row(b, dir, seg * SEGLEN + c * TB + t);
                Odir[((size_t)dir * M + row) * 1024 + h * 128 + wave * 32 + r32] = (bf16_t)(pk2(oacc[r], oacc[r]) & 0xffffu); } }
        HG_WRITE_SB();
        if (c + 1 < NBATCH) { HG_STAGE(c + 1); if (c + 2 < NBATCH) HG_GLOAD(c + 2); }
        __syncthreads();
    }
#undef HG_WRITE_SB
#undef HG_GLOAD
#undef HG_STAGE
}
__device__ __forceinline__ void hgrn_readout_phase(const bf16_t* Odir, const bf16_t* P, const float* og, bf16_t* YN, int gw, int NGW, int lane) {
    for (int r = gw; r < M; r += NGW) {
#pragma unroll
        for (int j = 0; j < 2; ++j) { const int col = j * 512 + lane * 8;
            const u32x4 a = *(const u32x4*)(Odir + (size_t)r * 1024 + col), bq = *(const u32x4*)(Odir + ((size_t)M + r) * 1024 + col), gt = *(const u32x4*)(P + (size_t)r * 5120 + 4096 + col);
            float y[8], gg[8]; float ss = 0.f;
#pragma unroll
            for (int q = 0; q < 4; ++q) { y[2 * q] = bflo(a[q]) + bflo(bq[q]); y[2 * q + 1] = bfhi(a[q]) + bfhi(bq[q]); gg[2 * q] = bflo(gt[q]); gg[2 * q + 1] = bfhi(gt[q]); }
#pragma unroll
            for (int e = 0; e < 8; ++e) ss += y[e] * y[e];
            const float rs = rsqrtf(sum16(ss) * (1.f / 128.f) + EPS);
            const f32x4 g0 = *(const f32x4*)(og + (col & 127)), g1 = *(const f32x4*)(og + (col & 127) + 4);
            float o[8];
#pragma unroll
            for (int e = 0; e < 8; ++e) o[e] = y[e] * rs * (e < 4 ? g0[e & 3] : g1[e & 3]) * silu_f(gg[e]);
            u32x4 w; w.x = pk2(o[0], o[1]); w.y = pk2(o[2], o[3]); w.z = pk2(o[4], o[5]); w.w = pk2(o[6], o[7]);
            *(u32x4*)(YN + (size_t)r * 1024 + col) = w; }
    }
}

__device__ __forceinline__ int tid_fresh() { int t = threadIdx.x; asm volatile("" : "+v"(t)); return t; }
#define TID_F (tid_fresh())
#define LANE_F (tid_fresh() & 63)
#define WAVE_F (__builtin_amdgcn_readfirstlane(tid_fresh() >> 6))
#define GW_F ((int)blockIdx.x * NWAVES + WAVE_F)
#define GTID_F ((int)blockIdx.x * NTHREADS + tid_fresh())
#define SCR_F ((LAS float*)(ldsl + WAVE_F * 16384))
#define IDLE_CONVERT(nwg, fn, lay) do { const int cut_ = (nwg) % G; if ((int)blockIdx.x >= cut_) fn(p, lay, SCR_F, ((int)blockIdx.x - cut_) * NWAVES + WAVE_F, (G - cut_) * NWAVES, LANE_F); } while (0)
#define IDLE_ADALN(nwg, lay) do { const int cut_ = (nwg) % G; if ((int)blockIdx.x >= cut_) adaln_phase(p, (LAS float*)ldsl, TID_F, (lay), (lay) + 1, (int)blockIdx.x - cut_, G - cut_); } while (0)
template <int LAYER>
__device__ __forceinline__ void layer_fn(const Params& p, const XcdBarrier& xbar, unsigned char* lds) {
    const int G = gridDim.x, NGW = G * NWAVES, NT = G * NTHREADS;
    LAS unsigned char* ldsl = (LAS unsigned char*)lds;
    unsigned char* ws = P_WS;
    float* mod = (float*)(ws + WS_MOD); const float* lbv = (const float*)(ws + WS_LB); const float* TA = (const float*)(ws + WS_TA); const float* TMt = (const float*)(ws + WS_TM);
    float* XC = (float*)(ws + WS_XC); float* XL = P_OUT;
    bf16_t* WM = (bf16_t*)(ws + WS_WM); bf16_t* WF = (bf16_t*)(ws + WS_WF); bf16_t* XN = (bf16_t*)(ws + WS_XN);
    bf16_t* UB = (bf16_t*)(ws + WS_U); bf16_t* GB = (bf16_t*)(ws + WS_G);
    (void)lbv; (void)TA; (void)TMt; (void)NT;
        constexpr int layer = LAYER; constexpr int kind = layer % 3, lj = layer / 3; constexpr bool last = layer == 3;
        const float* modl = mod + (size_t)layer * 3 * 6144;
        const float* xl_src = layer == 0 ? P_IN(0) : XL; const float* xc_src = layer == 0 ? P_IN(2) : XC;
        PH(2) prenorm_phase<false>(xl_src, xc_src, P_IN(6) + layer * 1024, modl, 0, XN, GW_F, NGW, LANE_F);
        xcd_barrier(xbar);
        if constexpr (kind == 0) {
            PH(3) { pg8::Gemm g{XN, WM, M, 4096, 1024}; pg8::StaticOrder S; S.init(M, 4096, G, (int)blockIdx.x);
              EpiGqaQKV E{UB, P_IN(13) + lj * 128, P_IN(14) + lj * 128, TA, (LAS float*)(ldsl + 132096)};
              pg8::gemm_phase<EpiGqaQKV, pg8::StaticOrder, true, true>(ldsl, g, S, E); }
            IDLE_CONVERT(66 * 16, convert_ffn_weights, layer);
            if constexpr (!last) IDLE_ADALN(66 * 16, layer + 1);
            xcd_barrier(xbar);
            PH(5) att::attn_phase<4096, 4096, 2048, 4, 8, 1>(UB, UB + 2048, UB + 3072, GB, !last, (char*)lds, 0.08838834764831845f);
            xcd_barrier(xbar);
            { if constexpr (!last) ctx_resid_gemm<2048>(GB, WM + (size_t)4096 * 1024, xc_src, XC, modl + 2 * 1024 + 2 * 6144, (char*)lds, TID_F);
              pg8::Gemm g{GB, WM + (size_t)4096 * 1024, M, 1024, 2048}; LatentOrder S; S.init(1024, G, (int)blockIdx.x); EpiResid E{xl_src, xc_src, XL, XC, modl + 2 * 1024};
              pg8::gemm_phase<EpiResid, LatentOrder, true, true>(ldsl, g, S, E); }
            xcd_barrier(xbar);
        } else if constexpr (kind == 1) {
            PH(3) { pg8::Gemm g{XN, WM, M, 5120, 1024}; pg8::StaticOrder S; S.init(M, 5120, G, (int)blockIdx.x); EpiStore E{UB, 5120};
              pg8::gemm_phase<EpiStore, pg8::StaticOrder, true, true>(ldsl, g, S, E); }
            IDLE_CONVERT(66 * 20, convert_ffn_weights, layer);
            IDLE_ADALN(66 * 20, layer + 1);
            xcd_barrier(xbar);
            bf16_t* Odir = GB; float* Lst = (float*)(ws + WS_G + 67 * MiB); float* Dst = (float*)(ws + WS_G + 99 * MiB + 512 * 1024);
            PH(7) for (int it = blockIdx.x; it < 32 * (NSEG - 1); it += G) { const int bdh = it / (NSEG - 1), seg = it - bdh * (NSEG - 1);
                hgrn_state_item(bdh * NSEG + seg, UB, lbv, Lst, Dst, (char*)lds, TID_F); }
            xcd_barrier(xbar);
            PH(8) for (int it = blockIdx.x; it < 32 * NSEG; it += G) { const int k_ = it / 32, seg = k_ < NSEG / 2 ? NSEG - 1 - k_ : k_ - NSEG / 2, bdh = it & 31;
                hgrn_out_item(bdh * NSEG + seg, UB, lbv, Lst, Dst, Odir, (char*)lds, TID_F); }
            xcd_barrier(xbar);
            PH(9) hgrn_readout_phase(Odir, UB, P_IN(17) + lj * 128, XN, GW_F, NGW, LANE_F);
            xcd_barrier(xbar);
            { ctx_resid_gemm<1024>(XN, WM + (size_t)5120 * 1024, xc_src, XC, modl + 2 * 1024 + 2 * 6144, (char*)lds, TID_F);
              pg8::Gemm g{XN, WM + (size_t)5120 * 1024, M, 1024, 1024}; LatentOrder S; S.init(1024, G, (int)blockIdx.x); EpiResid E{xl_src, xc_src, XL, XC, modl + 2 * 1024};
              pg8::gemm_phase<EpiResid, LatentOrder, true, true>(ldsl, g, S, E); }
            xcd_barrier(xbar);
        } else {
            bf16_t* P1 = GB; bf16_t* CQ = GB + (size_t)M * 1280; bf16_t* CKV = CQ + (size_t)M * 768;
            bf16_t* Qp = UB; bf16_t* Kp = UB + (size_t)M * 2048; bf16_t* Vp = Kp + (size_t)M * 2048;
            bf16_t* Wqb = WM + (size_t)1280 * 1024; bf16_t* Wkvb = Wqb + (size_t)1536 * 768; bf16_t* Wo = Wkvb + (size_t)2048 * 256;
            PH(3) { pg8::Gemm g{XN, WM, M, 1280, 1024}; pg8::StaticOrder S; S.init(M, 1280, G, (int)blockIdx.x); EpiStore E{P1, 1280};
              pg8::gemm_phase<EpiStore, pg8::StaticOrder, true, true>(ldsl, g, S, E); }
            IDLE_CONVERT(66 * 5, convert_ffn_weights, layer);
            IDLE_ADALN(66 * 5, layer + 1);
            xcd_barrier(xbar);
            PH(10) mla_norm_phase(P1, P_IN(21) + lj * 768, P_IN(22) + lj * 256, TMt, CQ, CKV, Qp, Kp, Vp, GW_F, NGW, LANE_F);
            xcd_barrier(xbar);
            PH(11) { pg8::Gemm g{CQ, Wqb, M, 1536, 768}; pg8::StaticOrder S; S.init(M, 1536, G, (int)blockIdx.x); EpiMlaQ E{Qp, TMt};
              pg8::gemm_phase<EpiMlaQ, pg8::StaticOrder, true, true>(ldsl, g, S, E); }
            PH(12) { pg8::Gemm g{CKV, Wkvb, M, 2048, 256}; pg8::StaticOrder S;
              { const int off_ = (66 * 6) % G; S.init(M, 2048, G, ((int)blockIdx.x - off_ + G) % G); } EpiMlaKV E{Kp, Vp};
              pg8::gemm_phase<EpiMlaKV, pg8::StaticOrder, false, false>(ldsl, g, S, E); }
            xcd_barrier(xbar);
            PH(13) att::attn_phase<2048, 2048, 1024, 2, 6, 0>(Qp, Kp, Vp, XN, !last, (char*)lds, 0.10206207261596575f);
            xcd_barrier(xbar);
            { ctx_resid_gemm<1024>(XN, Wo, xc_src, XC, modl + 2 * 1024 + 2 * 6144, (char*)lds, TID_F);
              pg8::Gemm g{XN, Wo, M, 1024, 1024}; LatentOrder S; S.init(1024, G, (int)blockIdx.x); EpiResid E{xl_src, xc_src, XL, XC, modl + 2 * 1024};
              pg8::gemm_phase<EpiResid, LatentOrder, true, true>(ldsl, g, S, E); }
            xcd_barrier(xbar);
        }
        PH(2) prenorm_phase<last, true>(XL, XC, P_IN(7) + layer * 1024, modl, 3, XN, GW_F, NGW, LANE_F);
        zero_xnf_guards(XN, TID_F);
        xcd_barrier(xbar);
        PH(3) { pg8::Gemm g{XN, WF, M, 6144, 1024}; FfnOrder<last> S; S.init(G, (int)blockIdx.x);
          EpiConvGate<last> E{GB, P_IN(9) + (size_t)layer * 3 * 6144, P_IN(10) + (size_t)layer * 6144, (LAS float*)(ldsl + 132096)};
          pg8::gemm_phase<EpiConvGate<last>, FfnOrder<last>, true, true>(ldsl, g, S, E); }
        if constexpr (!last) IDLE_CONVERT(70 * 24, convert_mixer_weights, layer + 1);
        xcd_barrier(xbar);
        { if constexpr (!last) ctx_resid_gemm<3072>(GB, WF + (size_t)6144 * 1024, XC, XC, modl + 5 * 1024 + 2 * 6144, (char*)lds, TID_F);
          pg8::Gemm g{GB, WF + (size_t)6144 * 1024, M, 1024, 3072}; LatentOrder S; S.init(1024, G, (int)blockIdx.x); EpiResid E{XL, XC, XL, XC, modl + 5 * 1024};
          pg8::gemm_phase<EpiResid, LatentOrder, true, true>(ldsl, g, S, E); }
        xcd_barrier(xbar);
}

__global__ void __launch_bounds__(NTHREADS, 2) fwd_megakernel(Params p) {
    extern __shared__ __attribute__((aligned(16))) unsigned char lds[];
    cg::grid_group grid = cg::this_grid();
    const int G = gridDim.x, NGW = G * NWAVES;
    LAS unsigned char* ldsl = (LAS unsigned char*)lds;
    volatile LAS unsigned* MISC = (volatile LAS unsigned*)(ldsl + MISC_OFF);
    if (threadIdx.x < 32) MISC[threadIdx.x] = 0u;
    __syncthreads();
    const XcdBarrier xbar = xcd_barrier_post((unsigned*)(P_WS + WS_BAR), MISC + 8);

    PH(0) { adaln_phase(p, (LAS float*)ldsl, TID_F, 0, 1, (int)blockIdx.x, G);
    tables_phase(p, TID_F); }
    __syncthreads();
    PH(1) convert_mixer_weights(p, 0, SCR_F, GW_F, NGW, LANE_F);
    grid.sync();

    layer_fn<0>(p, xbar, lds); layer_fn<1>(p, xbar, lds); layer_fn<2>(p, xbar, lds); layer_fn<3>(p, xbar, lds);
    for (int xs = 0; xs < XSYNC; ++xs) xcd_barrier(xbar);
    final_norm_phase(P_OUT, P_IN(26), GW_F, NGW, LANE_F);
}

extern "C" void kernel_launch(void* const* d_in, const int* in_sizes, int n_in, void* d_out, int out_size, void* d_ws, size_t ws_size, hipStream_t stream) {
    static int grid = 0;
    if (grid == 0) {
        if (n_in != 27 || in_sizes[0] != 2 * SEQ * D || out_size != 2 * SEQ * D || ws_size < WS_END) {
            fprintf(stderr, "kernel_launch: shape/workspace mismatch: n_in %d in0 %d out %d ws %zu (need %zu)\n", n_in, n_in > 0 ? in_sizes[0] : -1, out_size, ws_size, (size_t)WS_END); grid = -1; return; }
        int dev = 0, cus = 0, per_cu = 0;
        if (hipGetDevice(&dev) != hipSuccess || hipDeviceGetAttribute(&cus, hipDeviceAttributeMultiprocessorCount, dev) != hipSuccess) { grid = -1; return; }
        if (hipFuncSetAttribute((const void*)fwd_megakernel, hipFuncAttributeMaxDynamicSharedMemorySize, LDS_BYTES) != hipSuccess) { fprintf(stderr, "kernel_launch: hipFuncSetAttribute failed\n"); grid = -1; return; }
        if (hipOccupancyMaxActiveBlocksPerMultiprocessor(&per_cu, (const void*)fwd_megakernel, NTHREADS, LDS_BYTES) != hipSuccess || per_cu < 1) { fprintf(stderr, "kernel_launch: occupancy query gave %d\n", per_cu); per_cu = 1; }
        (void)hipGetLastError();
        grid = cus * 1;
    }
    if (grid < 0) return;
    if (hipMemsetAsync((char*)d_ws + WS_BAR, 0, WS_BAR_BYTES, stream) != hipSuccess) { fprintf(stderr, "kernel_launch: memset of barrier words failed\n"); return; }
    Params p{};
    for (int i = 0; i < 27; ++i) p.in[i] = (const float*)d_in[i];
    p.out = (float*)d_out; p.ws = (unsigned char*)d_ws;
    void* args[] = {&p};
    hipError_t e = hipLaunchCooperativeKernel((const void*)fwd_megakernel, dim3(grid), dim3(NTHREADS), args, LDS_BYTES, stream);
    if (e != hipSuccess) fprintf(stderr, "kernel_launch: cooperative launch failed: %s (grid %d)\n", hipGetErrorString(e), grid);
}
```

```cpp
#include <hip/hip_runtime.h>
#include <hip/hip_bf16.h>
#include <hip/hip_cooperative_groups.h>
#include <cstdio>
#include <cstdint>
namespace cg = cooperative_groups;

namespace pg8 {
#define PG8_LAS __attribute__((address_space(3)))
typedef unsigned short bf16_t;
typedef short bf16x8 __attribute__((ext_vector_type(8)));
typedef float f32x4 __attribute__((ext_vector_type(4)));
typedef unsigned u32x4 __attribute__((ext_vector_type(4)));
typedef unsigned u32x2 __attribute__((ext_vector_type(2)));
constexpr int BM = 256, BK = 64, HALF = 128, HTB = HALF * BK * 2, STAGE_BYTES = 8 * HTB, NXCD = 8, WGM = 8;

__host__ __device__ __forceinline__ int lds_byte(int r, int c) { const int st = (r >> 4) * 2 + (c >> 5), rr = r & 15, cc = c & 31, ob = rr * 64 + cc * 2; return st * 1024 + (ob ^ (((ob >> 9) & 1) << 5)); }
__host__ __device__ __forceinline__ void stage_rc(int b, int& R, int& C) { const int st = b / 1024, sb = b % 1024, swz = sb ^ (((sb >> 9) & 1) << 5); R = (st >> 1) * 16 + swz / 64; C = (st & 1) * 32 + (swz % 64) / 2; }
__host__ __device__ __forceinline__ int perm32(int rho) { const int n = rho >> 4, i = rho & 15; return 8 * (i >> 2) + 4 * n + (i & 3); }

struct Unit { int pm, pn; };
struct Gemm { const bf16_t* A; const bf16_t* Bt; int M, N, K; };

struct StaticOrder {
    int nM, nN, nwg, G, c;
    __host__ __device__ void init(int M, int N, int G_, int c_) { nM = M / BM; nN = N / BM; nwg = nM * nN; G = G_; c = c_; }
    __host__ __device__ bool next(int i, Unit& u) const {
        const long L = (long)i * G + c; if (L >= nwg) return false;
        int wgid = (int)L; { const int q = nwg / NXCD, r = nwg % NXCD, xcd = wgid % NXCD, off = wgid / NXCD; wgid = (xcd < r ? xcd * (q + 1) : r * (q + 1) + (xcd - r) * q) + off; }
        const int nig = WGM * nN, gid = wgid / nig, fm = gid * WGM, gsz = (nM - fm) < WGM ? (nM - fm) : WGM;
        u.pm = fm + ((wgid % nig) % gsz); u.pn = (wgid % nig) / gsz; return true;
    }
    __device__ __forceinline__ void a_ready(const Unit&) const {}
    __device__ __forceinline__ void done(const Unit&) const {}
    __device__ __forceinline__ size_t a_off(const Unit& u, size_t tstep) const { return (size_t)u.pm * tstep; }
};

__device__ __forceinline__ unsigned cvt_pk_bf16(float lo, float hi) { unsigned r; asm volatile("v_cvt_pk_bf16_f32 %0, %1, %2" : "=v"(r) : "v"(lo), "v"(hi)); return r; }


template <class Epi, class Sched, bool ALIGN_EPI = false, bool SP2 = false>
__device__ __forceinline__ void gemm_phase(PG8_LAS unsigned char* lds, const Gemm g, const Sched& S, const Epi& E) {
    int tid_ = threadIdx.x; asm volatile("" : "+v"(tid_));
    const int tid = tid_, wid = __builtin_amdgcn_readfirstlane(tid >> 6), lane = tid & 63, wr = wid >> 2, wc = wid & 3, fr = lane & 15, fq = lane >> 4;
    const int K = g.K, nt = K / BK;
    unsigned voffA[2], voffB[2];
#pragma unroll
    for (int i = 0; i < 2; ++i) { int R, C; stage_rc(tid * 16 + i * 8192, R, C); const int Rb = Epi::PERM ? ((R & ~31) + perm32(R & 31)) : R;
        voffA[i] = (unsigned)(R * K + C) * 2u; voffB[i] = (unsigned)(Rb * K + C) * 2u; }
    const size_t kstep = (size_t)(BK * 2);
    const size_t hstep = (size_t)HALF * K * 2;
    const size_t tstep = 2 * hstep;
    const unsigned ldsw = (unsigned)wid * 1024u;
    const int aoff = lds_byte(wr * 64 + fr, fq * 8), boff = lds_byte(wc * 32 + fr, fq * 8);
#define PG8_SA(b, h) (((b) * 2 + (h)) * HTB)
#define PG8_SB(b, h) ((4 + (b) * 2 + (h)) * HTB)
#define PG8_STAGE(bufoff, gbase, voff) do { _Pragma("unroll") for (int _i = 0; _i < 2; ++_i) \
        __builtin_amdgcn_global_load_lds((const unsigned*)((const char*)(gbase) + (voff)[_i]), (PG8_LAS unsigned*)(lds + (bufoff) + ldsw + _i * 8192), 16, 0, 0); } while (0)
#define PG8_LDA(dst, b, h) do { _Pragma("unroll") for (int m = 0; m < 4; ++m) _Pragma("unroll") for (int k = 0; k < 2; ++k) dst[m][k] = *(const PG8_LAS bf16x8*)(lds + PG8_SA(b, h) + aoff + m * 2048 + k * 1024); } while (0)
#define PG8_LDB(dst, b, h) do { _Pragma("unroll") for (int n = 0; n < 2; ++n) _Pragma("unroll") for (int k = 0; k < 2; ++k) dst[n][k] = *(const PG8_LAS bf16x8*)(lds + PG8_SB(b, h) + boff + n * 2048 + k * 1024); } while (0)
#define PG8_MMA(ai, bj, At, Bt) do { __builtin_amdgcn_s_setprio(1); _Pragma("unroll") for (int m = 0; m < 4; ++m) _Pragma("unroll") for (int n = 0; n < 2; ++n) _Pragma("unroll") for (int k = 0; k < 2; ++k) \
        acc[ai][bj][m][n] = __builtin_amdgcn_mfma_f32_16x16x32_bf16(Bt[n][k], At[m][k], acc[ai][bj][m][n], 0, 0, 0); __builtin_amdgcn_s_setprio(0); } while (0)
#define PG8_WAIT_V(n) asm volatile("s_waitcnt vmcnt(" #n ")" ::: "memory")
#define PG8_WAIT_L(n) asm volatile("s_waitcnt lgkmcnt(" #n ")" ::: "memory")
#define PG8_BAR __builtin_amdgcn_s_barrier()
#define PG8_SCHED __builtin_amdgcn_sched_barrier(0)
    Unit cur, nxt; int ui = 0;
    if (!S.next(0, cur)) return;
    f32x4 acc[2][2][4][2];
#pragma unroll
    for (int a = 0; a < 2; ++a)
#pragma unroll
        for (int b = 0; b < 2; ++b)
#pragma unroll
            for (int m = 0; m < 4; ++m)
#pragma unroll
                for (int n = 0; n < 2; ++n) acc[a][b][m][n] = (f32x4){0.f, 0.f, 0.f, 0.f};
    bf16x8 At[4][2], B0[2][2], B1[2][2];
    const char* cA = (const char*)g.A + S.a_off(cur, tstep); const char* cB = (const char*)g.Bt + (size_t)cur.pn * tstep;
    S.a_ready(cur);
    if constexpr (SP2) {
        PG8_STAGE(PG8_SB(0, 0), cB, voffB); PG8_STAGE(PG8_SB(0, 1), cB + hstep, voffB); PG8_STAGE(PG8_SA(0, 0), cA, voffA); PG8_STAGE(PG8_SA(0, 1), cA + hstep, voffA);
        if (wr == 1) PG8_BAR;
        PG8_WAIT_V(2); PG8_BAR;
        PG8_STAGE(PG8_SB(1, 0), cB + kstep, voffB); PG8_STAGE(PG8_SA(1, 0), cA + kstep, voffA); PG8_STAGE(PG8_SB(1, 1), cB + hstep + kstep, voffB);
        PG8_WAIT_V(6); PG8_BAR;
    } else {
        PG8_STAGE(PG8_SB(0, 0), cB, voffB); PG8_STAGE(PG8_SA(0, 0), cA, voffA); PG8_STAGE(PG8_SB(0, 1), cB + hstep, voffB); PG8_STAGE(PG8_SA(0, 1), cA + hstep, voffA);
        if (wr == 1) PG8_BAR;
        PG8_WAIT_V(4); PG8_BAR;
        PG8_STAGE(PG8_SB(1, 0), cB + kstep, voffB); PG8_STAGE(PG8_SA(1, 0), cA + kstep, voffA); PG8_STAGE(PG8_SB(1, 1), cB + hstep + kstep, voffB);
        PG8_WAIT_V(6); PG8_BAR;
    }
    for (;;) {
        const bool has_next = S.next(ui + 1, nxt);
        const char* nA = has_next ? (const char*)g.A + S.a_off(nxt, tstep) : cA; const char* nB = has_next ? (const char*)g.Bt + (size_t)nxt.pn * tstep : cB;
        for (int t = 0; t < nt; t += 2) {
            const bool last = (t == nt - 2);
            const char* a1 = cA + (size_t)(t + 1) * kstep;
            const char* a2 = last ? nA : cA + (size_t)(t + 2) * kstep; const char* b2 = last ? nB : cB + (size_t)(t + 2) * kstep;
            const char* a3 = a2 + kstep; const char* b3 = b2 + kstep;
            if (last && has_next) S.a_ready(nxt);
            if constexpr (SP2) {
            PG8_LDB(B0, 0, 0); PG8_LDB(B1, 0, 1); PG8_SCHED; PG8_LDA(At, 0, 0); PG8_STAGE(PG8_SA(1, 1), a1 + hstep, voffA);
            PG8_WAIT_V(8); PG8_WAIT_L(0); PG8_BAR; PG8_MMA(0, 0, At, B0); PG8_MMA(0, 1, At, B1); PG8_BAR; PG8_SCHED;
            PG8_LDA(At, 0, 1); PG8_STAGE(PG8_SB(0, 0), b2, voffB); PG8_STAGE(PG8_SB(0, 1), b2 + hstep, voffB); PG8_STAGE(PG8_SA(0, 0), a2, voffA);
            PG8_WAIT_V(8); PG8_WAIT_L(0); PG8_BAR; PG8_MMA(1, 0, At, B0); PG8_MMA(1, 1, At, B1); PG8_BAR; PG8_SCHED;
            PG8_LDB(B0, 1, 0); PG8_LDB(B1, 1, 1); PG8_SCHED; PG8_LDA(At, 1, 0); PG8_STAGE(PG8_SA(0, 1), a2 + hstep, voffA);
            PG8_WAIT_V(8); PG8_WAIT_L(0); PG8_BAR; PG8_MMA(0, 0, At, B0); PG8_MMA(0, 1, At, B1); PG8_BAR; PG8_SCHED;
            PG8_LDA(At, 1, 1); PG8_STAGE(PG8_SB(1, 0), b3, voffB); PG8_STAGE(PG8_SB(1, 1), b3 + hstep, voffB); PG8_STAGE(PG8_SA(1, 0), a3, voffA);
            PG8_WAIT_V(8); PG8_WAIT_L(0); PG8_BAR; PG8_MMA(1, 0, At, B0); PG8_MMA(1, 1, At, B1); PG8_BAR; PG8_SCHED;
            } else {
            PG8_LDB(B0, 0, 0); PG8_SCHED; PG8_LDA(At, 0, 0); PG8_STAGE(PG8_SA(1, 1), a1 + hstep, voffA);
            PG8_WAIT_L(8); PG8_BAR; PG8_WAIT_L(0); PG8_MMA(0, 0, At, B0); PG8_BAR; PG8_SCHED;
            PG8_LDB(B1, 0, 1); PG8_STAGE(PG8_SB(0, 0), b2, voffB);
            PG8_BAR; PG8_WAIT_L(0); PG8_MMA(0, 1, At, B1); PG8_BAR;
            PG8_LDA(At, 0, 1); PG8_STAGE(PG8_SA(0, 0), a2, voffA);
            PG8_BAR; PG8_WAIT_L(0); PG8_MMA(1, 0, At, B0); PG8_BAR; PG8_SCHED;
            PG8_STAGE(PG8_SB(0, 1), b2 + hstep, voffB);
            PG8_WAIT_V(6); PG8_BAR; PG8_MMA(1, 1, At, B1); PG8_BAR;
            PG8_LDB(B0, 1, 0); PG8_SCHED; PG8_LDA(At, 1, 0); PG8_STAGE(PG8_SA(0, 1), a2 + hstep, voffA);
            PG8_WAIT_L(8); PG8_BAR; PG8_WAIT_L(0); PG8_MMA(0, 0, At, B0); PG8_BAR; PG8_SCHED;
            PG8_LDB(B1, 1, 1); PG8_STAGE(PG8_SB(1, 0), b3, voffB);
            PG8_BAR; PG8_WAIT_L(0); PG8_MMA(0, 1, At, B1); PG8_BAR;
            PG8_LDA(At, 1, 1); PG8_STAGE(PG8_SA(1, 0), a3, voffA);
            PG8_BAR; PG8_WAIT_L(0); PG8_MMA(1, 0, At, B0); PG8_BAR; PG8_SCHED;
            PG8_STAGE(PG8_SB(1, 1), b3 + hstep, voffB);
            PG8_WAIT_V(6); PG8_BAR; PG8_MMA(1, 1, At, B1); PG8_BAR;
            }
        }
        if constexpr (ALIGN_EPI) { if (wr == 0) PG8_BAR; }
        E(acc, cur, wr, wc, fr, fq); S.done(cur);
        if (!has_next) break;
#pragma unroll
        for (int a = 0; a < 2; ++a)
#pragma unroll
            for (int b = 0; b < 2; ++b)
#pragma unroll
                for (int m = 0; m < 4; ++m)
#pragma unroll
                    for (int n = 0; n < 2; ++n) acc[a][b][m][n] = (f32x4){0.f, 0.f, 0.f, 0.f};
        cur = nxt; cA = nA; cB = nB; ++ui;
        if constexpr (ALIGN_EPI) { if (wr == 1) PG8_BAR; }
    }
    PG8_WAIT_V(0);
    if constexpr (!ALIGN_EPI) { if (wr == 0) PG8_BAR; }
    PG8_BAR;
#undef PG8_SA
#undef PG8_SB
#undef PG8_STAGE
#undef PG8_LDA
#undef PG8_LDB
#undef PG8_MMA
#undef PG8_WAIT_V
#undef PG8_WAIT_L
#undef PG8_BAR
#undef PG8_SCHED
}
}

typedef unsigned short bf16_t;
typedef short bf16x8 __attribute__((ext_vector_type(8)));
typedef short s16x4 __attribute__((ext_vector_type(4)));
typedef float f32x16 __attribute__((ext_vector_type(16)));
typedef float f32x4 __attribute__((ext_vector_type(4)));
typedef float f32x2 __attribute__((ext_vector_type(2)));
typedef unsigned u32x4 __attribute__((ext_vector_type(4)));
typedef unsigned u32x2 __attribute__((ext_vector_type(2)));
#define LAS __attribute__((address_space(3)))

constexpr int D = 1024, SEQ = 8192, CTXL = 256, RB = SEQ + CTXL  , M = 2 * RB  ;
constexpr int DFF = 3072;
constexpr float EPS = 1e-6f;
constexpr int NTHREADS = 512, NWAVES = 8;
constexpr int LDS_BYTES = 147456;
#ifndef DUPM
#define DUPM 0x0
#endif
#ifndef XSYNC
#define XSYNC 0
#endif
#define PH(b) _Pragma("unroll 1") for (int rep_ = 0; rep_ < ((((DUPM) >> (b)) & 1) ? 2 : 1); ++rep_)

constexpr size_t MiB = 1u << 20;
constexpr size_t WS_MOD = 0;
constexpr size_t WS_LB = 512 * 1024;
constexpr size_t WS_TA = 576 * 1024;
constexpr size_t WS_TM = 640 * 1024;
constexpr size_t WS_BAR = 1 * MiB;
constexpr size_t WS_BAR_BYTES = 16384;
constexpr int MISC_OFF = 131072 + 320;
constexpr size_t WS_XC = 2 * MiB;
constexpr size_t WS_WM = 4 * MiB;
constexpr size_t WS_WF = 17 * MiB;
constexpr size_t WS_XN = 36 * MiB;
constexpr size_t WS_U = 70 * MiB;
constexpr size_t WS_G = 270 * MiB;
constexpr size_t WS_END = 370 * MiB;

constexpr int XNF_BSTRIDE = 8450, XNF_ROWS = 16900 + 257;
__device__ __forceinline__ int xnf_row(int b, int t) { return b * XNF_BSTRIDE + t + 1 + (t >= SEQ ? 1 : 0); }
__device__ __forceinline__ void zero_xnf_guards(unsigned short* XNFb, int tid) {
    if (blockIdx.x != 0) return;
    const __attribute__((ext_vector_type(4))) unsigned z = {0u, 0u, 0u, 0u};
    for (int idx = tid; idx < (4 + 257) * 128; idx += 512) { const int q = idx >> 7, c16 = idx & 127;
        const int row = q == 0 ? 0 : (q == 1 ? 8193 : (q == 2 ? 8450 : (q == 3 ? 16643 : 16900 + (q - 4))));
        *(__attribute__((ext_vector_type(4))) unsigned*)(XNFb + (size_t)row * 1024 + c16 * 8) = z; }
}
__device__ __forceinline__ float bflo(unsigned w) { return __uint_as_float(w << 16); }
__device__ __forceinline__ float bfhi(unsigned w) { return __uint_as_float(w & 0xffff0000u); }
__device__ __forceinline__ float bf2f(bf16_t b) { return __uint_as_float((unsigned)b << 16); }
typedef __bf16 bf16x2_t __attribute__((ext_vector_type(2)));
__device__ __forceinline__ unsigned pk2(float lo, float hi) { f32x2 v = {lo, hi}; bf16x2_t b = __builtin_convertvector(v, bf16x2_t); return __builtin_bit_cast(unsigned, b); }
__device__ __forceinline__ float wave_sum(float v) {
#pragma unroll
    for (int o = 1; o < 64; o <<= 1) v += __shfl_xor(v, o);
    return v;
}
__device__ __forceinline__ float sum16(float v) { v += __shfl_xor(v, 1); v += __shfl_xor(v, 2); v += __shfl_xor(v, 4); v += __shfl_xor(v, 8); return v; }
__device__ __forceinline__ float silu_f(float v) { return v * __builtin_amdgcn_rcpf(1.f + __expf(-v)); }
__device__ __forceinline__ float sigmoid_f(float v) { return __builtin_amdgcn_rcpf(1.f + __expf(-v)); }


#define XB_TMO      128
#define XB_XCNT(j)  (256  + 64 * (j))
#define XB_XSUB(j)  (1280 + 64 * (j))
#define XB_XGEN(j)  (2304 + 64 * (j))
#define XB_TOP      3328
#define XB_TOPGEN   3392
#define XCD_BAR_WORDS 3456
#define XB_SPIN_CAP (1u << 18)
__device__ __forceinline__ unsigned xb_ld(unsigned* p)              { return __hip_atomic_load(p, __ATOMIC_RELAXED, __HIP_MEMORY_SCOPE_AGENT); }
__device__ __forceinline__ unsigned xb_add(unsigned* p, unsigned v) { return __hip_atomic_fetch_add(p, v, __ATOMIC_RELAXED, __HIP_MEMORY_SCOPE_AGENT); }
__device__ __forceinline__ unsigned xb_xcc_id() { return (unsigned)__builtin_amdgcn_s_getreg((3 << 11) | 20) & 0xFu; }
#define XB_SPIN(cond, bar) do { unsigned _sp = 0; while (cond) { __builtin_amdgcn_s_sleep(1); \
    if ((++_sp & 255u) == 0u) { if (xb_ld(&(bar)[XB_TMO])) break; if (_sp > XB_SPIN_CAP) { atomicAdd(&(bar)[XB_TMO], 1u); break; } } } } while (0)
struct XcdBarrier { unsigned* bar; unsigned x; volatile LAS unsigned* st; };
__device__ __forceinline__ XcdBarrier xcd_barrier_post(unsigned* bar, volatile LAS unsigned* st) {
    XcdBarrier b; b.bar = bar; b.x = xb_xcc_id(); b.st = st;
    if (threadIdx.x == 0) (void)xb_add(&bar[XB_XCNT(b.x)], 1u);
    return b;
}
__device__ __forceinline__ void xcd_barrier_complete(unsigned* bar, unsigned x, unsigned& nloc, unsigned& nx) {
    const unsigned G = gridDim.x * gridDim.y * gridDim.z;
    unsigned sum, cnt, mine, sp = 0u;
    for (;;) {
        sum = 0u; cnt = 0u; mine = 0u;
#pragma unroll
        for (unsigned j = 0; j < 16; ++j) { const unsigned c = xb_ld(&bar[XB_XCNT(j)]); sum += c; cnt += (c > 0u) ? 1u : 0u; mine = (j == x) ? c : mine; }
        if (sum == G) break;
        __builtin_amdgcn_s_sleep(1);
        if ((++sp & 255u) == 0u) { if (xb_ld(&bar[XB_TMO])) break; if (sp > XB_SPIN_CAP) { atomicAdd(&bar[XB_TMO], 1u); break; } }
    }
    nloc = mine > 0u ? mine : 1u; nx = cnt > 0u ? cnt : 1u;
}
__device__ __forceinline__ void xcd_barrier(const XcdBarrier& b) {
    asm volatile("s_waitcnt vmcnt(0)" ::: "memory");
    __syncthreads();
    if (threadIdx.x == 0) {
        unsigned* bar = b.bar;
        __builtin_amdgcn_s_waitcnt(0);
        unsigned nloc = b.st[0], nx = b.st[1];
        if (nloc == 0u) { xcd_barrier_complete(bar, b.x, nloc, nx); b.st[0] = nloc; b.st[1] = nx; }
        const unsigned old = xb_add(&bar[XB_XSUB(b.x)], 1u);
        const unsigned gen = old / nloc;
        if (old + 1u == (gen + 1u) * nloc) {
            __builtin_amdgcn_fence(__ATOMIC_RELEASE, "agent");
            asm volatile("s_waitcnt vmcnt(0)" ::: "memory");
            const unsigned og = xb_add(&bar[XB_TOP], 1u);
            const unsigned tg = og / nx;
            if (og + 1u == (tg + 1u) * nx) xb_add(&bar[XB_TOPGEN], 1u);
            else XB_SPIN(xb_ld(&bar[XB_TOPGEN]) == tg, bar);
            __builtin_amdgcn_fence(__ATOMIC_ACQUIRE, "agent");
            xb_add(&bar[XB_XGEN(b.x)], 1u);
            asm volatile("s_waitcnt vmcnt(0)" ::: "memory");
        } else {
            XB_SPIN(xb_ld(&bar[XB_XGEN(b.x)]) == gen, bar);
            __builtin_amdgcn_fence(__ATOMIC_ACQUIRE, "agent");
            asm volatile("s_waitcnt vmcnt(0)" ::: "memory");
        }
    }
    __syncthreads();
}

struct EpiStore {
    static constexpr bool PERM = true;
    bf16_t* O; int ldc;
    __device__ __forceinline__ void operator()(const f32x4 (&acc)[2][2][4][2], const pg8::Unit& u, int wr, int wc, int fr, int fq) const {
        bf16_t* base = O + (size_t)u.pm * 256 * ldc + u.pn * 256 + wc * 32;
        const int loff = (wr * 64 + fr) * ldc + 8 * fq;
#pragma unroll
        for (int ai = 0; ai < 2; ++ai)
#pragma unroll
            for (int m = 0; m < 4; ++m) {
#pragma unroll
                for (int bj = 0; bj < 2; ++bj) { const f32x4 v0 = acc[ai][bj][m][0], v1 = acc[ai][bj][m][1];
                    u32x4 w; w.x = pk2(v0[0], v0[1]); w.y = pk2(v0[2], v0[3]); w.z = pk2(v1[0], v1[1]); w.w = pk2(v1[2], v1[3]);
                    *(u32x4*)(base + loff + (ai * 128 + m * 16) * ldc + bj * 128) = w; } }
    }
};
struct EpiResid {
    static constexpr bool PERM = false;
    const float* slat; const float* sctx; float* dlat; float* dctx; const float* gate;
    __device__ __forceinline__ void operator()(const f32x4 (&acc)[2][2][4][2], const pg8::Unit& u, int wr, int wc, int fr, int fq) const {
        const int b = u.pm / 33, j = u.pm - b * 33;
        const size_t boff = (j < 32) ? ((size_t)b * SEQ + (size_t)j * 256) * D : (size_t)b * CTXL * D;
        const float* sb = (j < 32 ? slat : sctx) + boff; float* db = (j < 32 ? dlat : dctx) + boff;
        const float* g = gate + (j < 32 ? b : 2) * 6144 + u.pn * 256 + wc * 32;
        const int loff = (wr * 64 + fr) * D + u.pn * 256 + wc * 32 + 4 * fq;
#pragma unroll
        for (int bj = 0; bj < 2; ++bj)
#pragma unroll
            for (int n = 0; n < 2; ++n) { const f32x4 gv = *(const f32x4*)(g + 4 * fq + bj * 128 + n * 16);
#pragma unroll
                for (int ai = 0; ai < 2; ++ai)
#pragma unroll
                    for (int m = 0; m < 4; ++m) { const int off = loff + (ai * 128 + m * 16) * D + bj * 128 + n * 16;
                        const f32x4 x = *(const f32x4*)(sb + off); *(f32x4*)(db + off) = x + gv * acc[ai][bj][m][n]; }
                asm volatile("" ::: "memory"); }
    }
};
struct EpiMlaQ {
    static constexpr bool PERM = false;
    bf16_t* Qp; const float* TM;
    __device__ __forceinline__ void operator()(const f32x4 (&acc)[2][2][4][2], const pg8::Unit& u, int wr, int wc, int fr, int fq) const {
        const int b = u.pm / 33, j = u.pm - b * 33; const bool lat = j < 32;
#pragma unroll
        for (int bj = 0; bj < 2; ++bj) {
            const int blk = u.pn * 8 + bj * 4 + wc, h = blk / 3, part = blk - 3 * h;
#pragma unroll
            for (int ai = 0; ai < 2; ++ai)
#pragma unroll
                for (int m = 0; m < 4; ++m) { const int rl = ai * 128 + wr * 64 + m * 16 + fr; const size_t row = (size_t)u.pm * 256 + rl;
                    f32x4 v0 = acc[ai][bj][m][0], v1 = acc[ai][bj][m][1];
                    if (part == 2 && lat) { const int t = j * 256 + rl, ri = t >> 6, ci = t & 63;
#pragma unroll
                        for (int e = 0; e < 4; ++e) { const int jj = 4 * fq + e; const int pos = jj < 8 ? ri : ci; const f32x2 cs = *(const f32x2*)(TM + (pos * 8 + (jj & 7)) * 2);
                            const float x1 = v0[e], x2 = v1[e]; v0[e] = x1 * cs.x - x2 * cs.y; v1[e] = x1 * cs.y + x2 * cs.x; } }
                    bf16_t* p = Qp + row * 2048 + h * 128 + part * 32 + 4 * fq;
                    u32x2 w0; w0.x = pk2(v0[0], v0[1]); w0.y = pk2(v0[2], v0[3]); u32x2 w1; w1.x = pk2(v1[0], v1[1]); w1.y = pk2(v1[2], v1[3]);
                    *(u32x2*)p = w0; *(u32x2*)(p + 16) = w1; }
        }
    }
};
struct EpiMlaKV {
    static constexpr bool PERM = true;
    bf16_t* Kp; bf16_t* Vp;
    __device__ __forceinline__ void operator()(const f32x4 (&acc)[2][2][4][2], const pg8::Unit& u, int wr, int wc, int fr, int fq) const {
        bf16_t* base = ((wc < 2) ? Kp : Vp) + (size_t)u.pm * 256 * 2048 + u.pn * 256 + (wc & 1) * 32;
        const int loff = (wr * 64 + fr) * 2048 + 8 * fq;
#pragma unroll
        for (int ai = 0; ai < 2; ++ai)
#pragma unroll
            for (int m = 0; m < 4; ++m) {
#pragma unroll
                for (int bj = 0; bj < 2; ++bj) { const f32x4 v0 = acc[ai][bj][m][0], v1 = acc[ai][bj][m][1];
                    u32x4 w; w.x = pk2(v0[0], v0[1]); w.y = pk2(v0[2], v0[3]); w.z = pk2(v1[0], v1[1]); w.w = pk2(v1[2], v1[3]);
                    *(u32x4*)(base + loff + (ai * 128 + m * 16) * 2048 + bj * 128) = w; } }
    }
};

struct LatentOrder {
    pg8::StaticOrder so;
    __device__ void init(int N, int G, int c) { so.init(2 * SEQ, N, G, c); }
    __device__ bool next(int i, pg8::Unit& u) const { if (!so.next(i, u)) return false; u.pm += (u.pm >= 32) ? 1 : 0; return true; }
    __device__ __forceinline__ void a_ready(const pg8::Unit&) const {}
    __device__ __forceinline__ void done(const pg8::Unit&) const {}
    __device__ __forceinline__ size_t a_off(const pg8::Unit& u, size_t tstep) const { return (size_t)u.pm * tstep; }
};
template <int K>
__device__ __forceinline__ void ctx_resid_gemm(const bf16_t* __restrict__ A, const bf16_t* __restrict__ Bt, const float* sctx, float* dctx, const float* gate_ctx, char* lds, int tid) {
    const int wave = tid >> 6, lane = tid & 63, r32 = lane & 31, hi = lane >> 5;
    float* Pp = (float*)lds;
    for (int tile = blockIdx.x; tile < 256; tile += gridDim.x) {
        const int rt = tile >> 4, ct = tile & 15, crow0 = rt * 32, b = crow0 >> 8, within = crow0 & 255;
        const bf16_t* Ap = A + ((size_t)b * RB + SEQ + within + r32) * K + wave * (K / 8) + hi * 8;
        const bf16_t* Bp = Bt + ((size_t)ct * 64 + r32) * K + wave * (K / 8) + hi * 8;
        f32x16 acc0 = {}, acc1 = {};
#pragma unroll 8
        for (int kk = 0; kk < K / 8; kk += 16) {
            const bf16x8 a = *(const bf16x8*)(Ap + kk), b0 = *(const bf16x8*)(Bp + kk), b1 = *(const bf16x8*)(Bp + (size_t)32 * K + kk);
            acc0 = __builtin_amdgcn_mfma_f32_32x32x16_bf16(a, b0, acc0, 0, 0, 0);
            acc1 = __builtin_amdgcn_mfma_f32_32x32x16_bf16(a, b1, acc1, 0, 0, 0);
        }
#pragma unroll
        for (int r = 0; r < 16; ++r) { const int row = (r & 3) + 8 * (r >> 2) + 4 * hi; Pp[(wave * 32 + row) * 64 + r32] = acc0[r]; Pp[(wave * 32 + row) * 64 + 32 + r32] = acc1[r]; }
        __syncthreads();
        { const int row = tid >> 4, c4 = (tid & 15) * 4; f32x4 v = *(const f32x4*)(Pp + row * 64 + c4);
#pragma unroll
          for (int w = 1; w < 8; ++w) v += *(const f32x4*)(Pp + (w * 32 + row) * 64 + c4);
          const int col = ct * 64 + c4; const size_t off = (size_t)(crow0 + row) * D + col;
          const f32x4 g = *(const f32x4*)(gate_ctx + col), x = *(const f32x4*)(sctx + off);
          *(f32x4*)(dctx + off) = x + g * v; }
        __syncthreads();
    }
}

template <bool LASTL>
struct FfnOrder {
    pg8::StaticOrder so;
    __device__ void init(int G, int c) { so.init((LASTL ? 66 : 70) * 256, 6144, G, c); }
    __device__ bool next(int i, pg8::Unit& u) const { return so.next(i, u); }
    __device__ __forceinline__ void a_ready(const pg8::Unit&) const {}
    __device__ __forceinline__ void done(const pg8::Unit&) const {}
    __device__ __forceinline__ size_t a_off(const pg8::Unit& u, size_t tstep) const {
        int b, tt, isctx;
        if (LASTL) { b = u.pm / 33; tt = u.pm - b * 33; isctx = 0; } else { b = u.pm / 35; const int j = u.pm - b * 35; isctx = j >= 33; tt = isctx ? j - 33 : j; }
        const int row = b * XNF_BSTRIDE + (isctx ? SEQ + 1 : 0) + 254 * tt;
        return (size_t)row * (tstep / 256);
    }
};
template <int CTRL> __device__ __forceinline__ float dppf(float oldv, float src) {
    return __int_as_float(__builtin_amdgcn_update_dpp(__float_as_int(oldv), __float_as_int(src), CTRL, 0xf, 0xf, false));
}
template <bool LASTL>
struct EpiConvGate {
    static constexpr bool PERM = true;
    bf16_t* Gb; const float* cw; const float* cb; LAS float* H;
    __device__ __forceinline__ void operator()(const f32x4 (&acc)[2][2][4][2], const pg8::Unit& u, int wr, int wc, int fr, int fq) const {
        int b, tt, isctx;
        if (LASTL) { b = u.pm / 33; tt = u.pm - b * 33; isctx = 0; } else { b = u.pm / 35; const int j = u.pm - b * 35; isctx = j >= 33; tt = isctx ? j - 33 : j; }
        const int L = isctx ? CTXL : SEQ, mbase = b * RB + (isctx ? SEQ : 0), s0 = 254 * tt - 1;
        int frl = fr, fql = fq;
        asm volatile("" : "+v"(frl), "+v"(fql));
        const int cl = wc * 32 + 8 * fql;
        bf16_t* gbase = Gb + ((long)(mbase + s0) * DFF + u.pn * 128);
        { LAS float* sink = H + 3072 + ((wr * 4 + wc) * 64 + fql * 16 + frl) % 192 * 4;
#pragma unroll
          for (int ai = 0; ai < 2; ++ai) { const int B = ai * 2 + wr;
#pragma unroll
            for (int bj = 0; bj < 2; ++bj)
#pragma unroll
                for (int n = 0; n < 2; ++n) {
                    LAS float* p0 = (frl == 0) ? H + (((B * 2 + 0) * 2 + bj) * 128 + cl + 4 * n) : sink;
                    LAS float* p1 = (frl == 15) ? H + (((B * 2 + 1) * 2 + bj) * 128 + cl + 4 * n) : sink;
                    *(LAS f32x4*)p0 = acc[ai][bj][0][n]; *(LAS f32x4*)p1 = acc[ai][bj][3][n]; } } }
        LAS float* Wl = H + 2048;
        { const int tix = (wr * 4 + wc) * 64 + fql * 16 + frl;
          const int arr = tix >> 5, c4 = (tix & 31) * 4, so = (arr & 1) * 3072 + u.pn * 128 + c4;
          if (tix < 192) *(LAS f32x4*)(Wl + arr * 128 + c4) = *(const f32x4*)(cw + (arr >> 1) * 6144 + so);
          else if (tix < 256) *(LAS f32x4*)(Wl + arr * 128 + c4) = *(const f32x4*)(cb + so); }
        asm volatile("s_waitcnt vmcnt(0) lgkmcnt(0)" ::: "memory"); __builtin_amdgcn_s_barrier(); asm volatile("" ::: "memory");
#pragma unroll
        for (int n = 0; n < 2; ++n) {
#pragma unroll
            for (int ai = 0; ai < 2; ++ai) { const int B = ai * 2 + wr;
                const int Bp = B > 0 ? B - 1 : 0, Bn = B < 3 ? B + 1 : 3;
                unsigned lo[4];
#pragma unroll
                for (int ep = 0; ep < 2; ++ep) {
                    float g0[4];
#pragma unroll
                    for (int e1 = 0; e1 < 2; ++e1) { const int e = 2 * ep + e1; const LAS float* wp = Wl + cl + 4 * n + e; const LAS float* hp = H + cl + 4 * n + e;
                        const float wa0 = wp[0], wv0 = wp[128], wa1 = wp[256], wv1 = wp[384], wa2 = wp[512], wv2 = wp[640], ba = wp[768], bv = wp[896];
                        float pa[4], pv[4];
#pragma unroll
                        for (int m = 0; m < 4; ++m) { pa[m] = acc[ai][0][m][n][e]; pv[m] = acc[ai][1][m][n][e]; }
#pragma unroll
                        for (int m = 0; m < 4; ++m) {
                            const float pra = dppf<0x111>(m > 0 ? dppf<0x121>(0.f, pa[m - 1]) : hp[((Bp * 2 + 1) * 2 + 0) * 128], pa[m]), nxa = dppf<0x101>(m < 3 ? dppf<0x12F>(0.f, pa[m + 1]) : hp[((Bn * 2 + 0) * 2 + 0) * 128], pa[m]);
                            const float prv = dppf<0x111>(m > 0 ? dppf<0x121>(0.f, pv[m - 1]) : hp[((Bp * 2 + 1) * 2 + 1) * 128], pv[m]), nxv = dppf<0x101>(m < 3 ? dppf<0x12F>(0.f, pv[m + 1]) : hp[((Bn * 2 + 0) * 2 + 1) * 128], pv[m]);
                            const float av = ba + wa0 * pra + wa1 * pa[m] + wa2 * nxa, vv = bv + wv0 * prv + wv1 * pv[m] + wv2 * nxv;
                            const float gv = silu_f(av) * vv;
                            if (e1 == 0) g0[m] = gv;
                            else { const unsigned w = pk2(g0[m], gv);
                                if (ep == 0) lo[m] = w;
                                else { const int rl = B * 64 + m * 16 + frl, sq = s0 + rl;
                                    if (rl >= 1 && rl <= 254 && sq < L) { u32x2 w2; w2.x = lo[m]; w2.y = w; *(u32x2*)(gbase + (rl * DFF + cl + 4 * n)) = w2; } } } } }
                }
            }
        }
    }
};

struct EpiGqaQKV {
    static constexpr bool PERM = true;
    bf16_t* O; const float* qg; const float* kg; const float* TA; LAS float* Pn;
    __device__ __forceinline__ void operator()(const f32x4 (&acc)[2][2][4][2], const pg8::Unit& u, int wr, int wc, int fr, int fq) const {
        int frl = fr, fql = fq;
        asm volatile("" : "+v"(frl), "+v"(fql));
        bf16_t* base = O + (size_t)u.pm * 256 * 4096 + u.pn * 256 + wc * 32;
        const int loff = (wr * 64 + frl) * 4096 + 8 * fql;
        if (u.pn >= 12) {
#pragma unroll
            for (int ai = 0; ai < 2; ++ai)
#pragma unroll
                for (int m = 0; m < 4; ++m)
#pragma unroll
                    for (int bj = 0; bj < 2; ++bj) { const f32x4 v0 = acc[ai][bj][m][0], v1 = acc[ai][bj][m][1];
                        u32x4 w; w.x = pk2(v0[0], v0[1]); w.y = pk2(v0[2], v0[3]); w.z = pk2(v1[0], v1[1]); w.w = pk2(v1[2], v1[3]);
                        *(u32x4*)(base + loff + (ai * 128 + m * 16) * 4096 + bj * 128) = w; }
            return;
        }
#pragma unroll
        for (int ai = 0; ai < 2; ++ai)
#pragma unroll
            for (int m = 0; m < 4; ++m)
#pragma unroll
                for (int bj = 0; bj < 2; ++bj) { const f32x4 a = acc[ai][bj][m][0], c = acc[ai][bj][m][1];
                    float ss = (a[0] * a[0] + a[1] * a[1]) + (a[2] * a[2] + a[3] * a[3]) + (c[0] * c[0] + c[1] * c[1]) + (c[2] * c[2] + c[3] * c[3]);
                    ss += __shfl_xor(ss, 16); ss += __shfl_xor(ss, 32);
                    if (fql == 0) Pn[((ai * 128 + wr * 64 + m * 16 + frl) * 2 + bj) * 4 + wc] = ss; }
        asm volatile("s_waitcnt lgkmcnt(0)" ::: "memory"); __builtin_amdgcn_s_barrier(); asm volatile("" ::: "memory");
        const int b = u.pm / 33, jt = u.pm - b * 33; const bool lat = jt < 32;
        const float* gn = (u.pn < 8 ? qg : kg) + 16 * wc + 4 * fql;
        const f32x4 g1 = *(const f32x4*)gn, g2 = *(const f32x4*)(gn + 64);
#pragma unroll
        for (int ai = 0; ai < 2; ++ai)
#pragma unroll
            for (int m = 0; m < 4; ++m) { const int rl = ai * 128 + wr * 64 + m * 16 + frl; const int t = jt * 256 + rl, pos = (wc < 2) ? (t >> 6) : (t & 63);
                f32x2 cs[4];
#pragma unroll
                for (int e = 0; e < 4; ++e) cs[e] = lat ? *(const f32x2*)(TA + (pos * 32 + ((16 * wc + 4 * fql + e) & 31)) * 2) : (f32x2){1.f, 0.f};
#pragma unroll
                for (int bj = 0; bj < 2; ++bj) { const f32x4 p4 = *(const LAS f32x4*)(Pn + (rl * 2 + bj) * 4);
                    const float rs = rsqrtf(((p4.x + p4.y) + (p4.z + p4.w)) * (1.f / 128.f) + EPS);
                    const f32x4 x1 = acc[ai][bj][m][0], x2 = acc[ai][bj][m][1]; float o1[4], o2[4];
#pragma unroll
                    for (int e = 0; e < 4; ++e) { const float y1 = x1[e] * rs * g1[e], y2 = x2[e] * rs * g2[e]; o1[e] = y1 * cs[e].x - y2 * cs[e].y; o2[e] = y1 * cs[e].y + y2 * cs[e].x; }
                    u32x4 w; w.x = pk2(o1[0], o1[1]); w.y = pk2(o1[2], o1[3]); w.z = pk2(o2[0], o2[1]); w.w = pk2(o2[2], o2[3]);
                    *(u32x4*)(base + loff + (ai * 128 + m * 16) * 4096 + bj * 128) = w; } }
    }
};

namespace att {
constexpr int NW = 8, QBLK = 32, KVBLK = 64;
constexpr float THR = 8.f;
constexpr size_t SHM_V = KVBLK * 128 * 2, SHM_K = KVBLK * 128 * 2, SHM_ATTN = 2 * SHM_V + 2 * SHM_K + NW * 64 * 4;
#define KSWZ(row, colB) ((row) * 256 + ((colB) ^ (((row) & 7) << 4)))
#define SBAR() __builtin_amdgcn_sched_barrier(0)
__device__ __forceinline__ int crow(int r, int hi) { return (r & 3) + 8 * (r >> 2) + 4 * hi; }
__device__ __forceinline__ unsigned cvtpk(float lo, float hi) { unsigned r; asm volatile("v_cvt_pk_bf16_f32 %0, %1, %2" : "=v"(r) : "v"(lo), "v"(hi)); return r; }

__device__ __forceinline__ void partialSM(f32x16& p0, f32x16& p1, float& m_reg, float& mn, float& alpha, const float C, const float thr) {
  float pmax = p0[0];
#pragma unroll
  for (int r = 1; r < 16; ++r) pmax = fmaxf(pmax, p0[r]);
#pragma unroll
  for (int r = 0; r < 16; ++r) pmax = fmaxf(pmax, p1[r]);
  { auto rr = __builtin_amdgcn_permlane32_swap(__float_as_uint(pmax), __float_as_uint(pmax), false, false);
    pmax = fmaxf(__uint_as_float(rr[0]), __uint_as_float(rr[1])); }
  if (__builtin_expect(__all(pmax - m_reg <= thr), 1)) { mn = m_reg; alpha = 1.f; }
  else { mn = fmaxf(m_reg, pmax); alpha = __builtin_amdgcn_exp2f((m_reg - mn) * C); m_reg = mn; }
  float mnC = -mn * C;
#pragma unroll
  for (int r = 0; r < 16; ++r) p0[r] = fmaf(p0[r], C, mnC);
#pragma unroll
  for (int r = 0; r < 16; ++r) p1[r] = fmaf(p1[r], C, mnC);
#pragma unroll
  for (int r = 0; r < 16; ++r) p0[r] = __builtin_amdgcn_exp2f(p0[r]);
}
__device__ __forceinline__ void finishSM(f32x16& p0, f32x16& p1, float alpha, float& l_reg, bf16x8& pa0, bf16x8& pa1, bf16x8& pa2, bf16x8& pa3) {
#pragma unroll
  for (int r = 0; r < 16; ++r) p1[r] = __builtin_amdgcn_exp2f(p1[r]);
  float ps = 0;
#pragma unroll
  for (int r = 0; r < 16; ++r) ps += p0[r];
#pragma unroll
  for (int r = 0; r < 16; ++r) ps += p1[r];
  { auto rr = __builtin_amdgcn_permlane32_swap(__float_as_uint(ps), __float_as_uint(ps), false, false);
    ps = __uint_as_float(rr[0]) + __uint_as_float(rr[1]); }
  l_reg = l_reg * alpha + ps;
#define PK4(P, BASE, OUT) do { unsigned a0 = cvtpk(P[BASE + 0], P[BASE + 1]), a1 = cvtpk(P[BASE + 2], P[BASE + 3]);   \
    unsigned b0 = cvtpk(P[BASE + 4], P[BASE + 5]), b1 = cvtpk(P[BASE + 6], P[BASE + 7]);                              \
    auto r0 = __builtin_amdgcn_permlane32_swap(a0, b0, false, false); auto r1 = __builtin_amdgcn_permlane32_swap(a1, b1, false, false); \
    u32x4 w = {r0[0], r1[0], r0[1], r1[1]}; OUT = *reinterpret_cast<bf16x8*>(&w); } while (0)
  PK4(p0, 0, pa0); PK4(p0, 8, pa1); PK4(p1, 0, pa2); PK4(p1, 8, pa3);
#undef PK4
}
template <int KS>
__device__ __forceinline__ void qkt(f32x16& p0, f32x16& p1, const bf16_t* Ks, const bf16x8* qr, int r32, int hi) {
  p0 = f32x16{}; p1 = f32x16{};
#pragma unroll
  for (int d0 = 0; d0 < KS; ++d0) { int cb = (d0 * 16 + hi * 8) * 2;
    bf16x8 b0 = *reinterpret_cast<const bf16x8*>((const char*)Ks + KSWZ(r32, cb));
    bf16x8 b1 = *reinterpret_cast<const bf16x8*>((const char*)Ks + KSWZ(32 + r32, cb));
    p0 = __builtin_amdgcn_mfma_f32_32x32x16_bf16(b0, qr[d0], p0, 0, 0, 0);
    p1 = __builtin_amdgcn_mfma_f32_32x32x16_bf16(b1, qr[d0], p1, 0, 0, 0); }
}
__device__ __forceinline__ int v_st(int k, int c) { const int kk = (k & ~0xC) | ((k & 4) << 1) | ((k & 8) >> 1); return ((kk >> 3) * 4 + (c >> 5)) * 512 + ((kk & 7) * 32 + (c & 31)) * 2; }
__device__ __forceinline__ int v_rd_base(int lane) { return ((lane & 3) << 3) | (((lane >> 2) & 3) << 6) | (((lane >> 4) & 1) << 5) | (((lane >> 5) & 1) << 8); }
constexpr int v_rd_off(int d0, int ks, int half) { return d0 * 512 + ks * 4096 + half * 2048; }
template <int OFF> __device__ __forceinline__ s16x4 tr_read(int vb) {
  s16x4 r; asm volatile("ds_read_b64_tr_b16 %0, %1 offset:%2" : "=&v"(r) : "v"(vb), "i"(OFF) : "memory"); return r;
}
template <int D0> __device__ __forceinline__ void pv_one(f32x16& od, int vb, bf16x8 pa0, bf16x8 pa1, bf16x8 pa2, bf16x8 pa3) {
  const s16x4 l0 = tr_read<v_rd_off(D0, 0, 0)>(vb), h0 = tr_read<v_rd_off(D0, 0, 1)>(vb), l1 = tr_read<v_rd_off(D0, 1, 0)>(vb), h1 = tr_read<v_rd_off(D0, 1, 1)>(vb);
  const s16x4 l2 = tr_read<v_rd_off(D0, 2, 0)>(vb), h2 = tr_read<v_rd_off(D0, 2, 1)>(vb), l3 = tr_read<v_rd_off(D0, 3, 0)>(vb), h3 = tr_read<v_rd_off(D0, 3, 1)>(vb);
  asm volatile("s_waitcnt lgkmcnt(0)" ::: "memory"); SBAR();
#define PK(L, H) (bf16x8){L[0], L[1], L[2], L[3], H[0], H[1], H[2], H[3]}
  od = __builtin_amdgcn_mfma_f32_32x32x16_bf16(pa0, PK(l0, h0), od, 0, 0, 0);
  od = __builtin_amdgcn_mfma_f32_32x32x16_bf16(pa1, PK(l1, h1), od, 0, 0, 0);
  od = __builtin_amdgcn_mfma_f32_32x32x16_bf16(pa2, PK(l2, h2), od, 0, 0, 0);
  od = __builtin_amdgcn_mfma_f32_32x32x16_bf16(pa3, PK(l3, h3), od, 0, 0, 0);
#undef PK
}
template <int NOB>
__device__ __forceinline__ void pv_d0(f32x16* o, int vb, bf16x8 pa0, bf16x8 pa1, bf16x8 pa2, bf16x8 pa3) {
  pv_one<0>(o[0], vb, pa0, pa1, pa2, pa3); pv_one<1>(o[1], vb, pa0, pa1, pa2, pa3);
  if constexpr (NOB == 4) { pv_one<2>(o[2], vb, pa0, pa1, pa2, pa3); pv_one<3>(o[3], vb, pa0, pa1, pa2, pa3); }
}

template <int LDQ, int LDK, int LDO, int NOB, int KS>
__device__ __forceinline__ void attn_dense_body(const bf16_t* __restrict__ Qb, const bf16_t* __restrict__ Kh, const bf16_t* __restrict__ Vh,
                                                bf16_t* __restrict__ Ob, int seq, char* lds, const float C, const float thr) {
  int tid_ = threadIdx.x; asm volatile("" : "+v"(tid_));
  const int tid = tid_, wid = tid >> 6, lane = tid & 63, r32 = lane & 31, hi = lane >> 5;
  bf16_t* V_lds = (bf16_t*)lds; bf16_t* K_lds = (bf16_t*)(lds + 2 * SHM_V);
  float* ws = (float*)(lds + 2 * SHM_V + 2 * SHM_K) + wid * 64; float* li_l = ws; float* al_l = ws + 32;
  float m_reg = -1e30f, l_reg = 0; f32x16 o[4] = {}; bf16x8 qr[8];
  const bf16_t* Qw = Qb + (long)(wid * QBLK + r32) * LDQ + hi * 8;
#pragma unroll
  for (int d0 = 0; d0 < KS; ++d0) qr[d0] = *reinterpret_cast<const bf16x8*>(Qw + d0 * 16);
  const int sr = tid >> 4, sc = (tid & 15) * 8, vst0 = v_st(sr, sc), vst1 = v_st(32 + sr, sc);
  const int vb0 = (int)(uintptr_t)V_lds + v_rd_base(lane);
  const bool kact = sc < KS * 16, vact = sc < NOB * 32;
  struct { bf16x8 vs0, vs1, ks0, ks1; } sr_[1];
#define SLOAD(i, k0) do { if (vact) { sr_[i].vs0 = *reinterpret_cast<const bf16x8*>(&Vh[(long)((k0) + sr) * LDK + sc]); sr_[i].vs1 = *reinterpret_cast<const bf16x8*>(&Vh[(long)((k0) + 32 + sr) * LDK + sc]); } \
    if (kact) { sr_[i].ks0 = *reinterpret_cast<const bf16x8*>(&Kh[(long)((k0) + sr) * LDK + sc]); sr_[i].ks1 = *reinterpret_cast<const bf16x8*>(&Kh[(long)((k0) + 32 + sr) * LDK + sc]); } } while (0)
#define SWRITE(b, i) do { if (vact) { *(bf16x8*)((char*)V_lds + (b) * SHM_V + vst0) = sr_[i].vs0;          \
    *(bf16x8*)((char*)V_lds + (b) * SHM_V + vst1) = sr_[i].vs1; } int kc = sc * 2;               \
    if (kact) { *(bf16x8*)((char*)K_lds + (b) * SHM_K + KSWZ(sr, kc)) = sr_[i].ks0;                       \
    *(bf16x8*)((char*)K_lds + (b) * SHM_K + KSWZ(32 + sr, kc)) = sr_[i].ks1; } } while (0)
#define SWAIT() asm volatile("s_waitcnt vmcnt(0)" ::: "memory")
#define RESC(a) do { if (__any((a) < 1.f)) { if (hi == 0) al_l[r32] = (a); asm volatile("s_waitcnt lgkmcnt(0)" ::: "memory"); \
    _Pragma("unroll") for (int d = 0; d < NOB; ++d) _Pragma("unroll") for (int r = 0; r < 16; ++r) o[d][r] *= al_l[crow(r, hi)]; } } while (0)
  f32x16 pA0, pA1, pB0, pB1; float mnA, mnB, alA, alB; bf16x8 pa0, pa1, pa2, pa3; const int NT = seq / KVBLK;
  constexpr int SE = 0, SO = 0;
  if (__builtin_amdgcn_readfirstlane(tid) >= 256) __builtin_amdgcn_s_setprio(1);
  SLOAD(SE, 0); asm volatile("s_waitcnt vmcnt(0)" ::: "memory"); SWRITE(0, SE); __syncthreads();
  qkt<KS>(pA0, pA1, K_lds, qr, r32, hi); partialSM(pA0, pA1, m_reg, mnA, alA, C, thr);
  SLOAD(SO, KVBLK);
  SWAIT(); SWRITE(1, SO); __syncthreads();
  for (int j = 1; j + 1 < NT; j += 2) {
    SBAR(); qkt<KS>(pB0, pB1, (bf16_t*)((char*)K_lds + SHM_K), qr, r32, hi);
    finishSM(pA0, pA1, alA, l_reg, pa0, pa1, pa2, pa3); SBAR();
    SLOAD(SO, (j + 1) * KVBLK); SBAR();
    pv_d0<NOB>(o, vb0, pa0, pa1, pa2, pa3); partialSM(pB0, pB1, m_reg, mnB, alB, C, thr);
    __syncthreads(); SWAIT(); SWRITE(0, SE);
    RESC(alB); __syncthreads();
    SBAR(); qkt<KS>(pA0, pA1, K_lds, qr, r32, hi);
    finishSM(pB0, pB1, alB, l_reg, pa0, pa1, pa2, pa3); SBAR();
    SLOAD(SE, (j + 2) * KVBLK); SBAR();
    pv_d0<NOB>(o, vb0 + (int)SHM_V, pa0, pa1, pa2, pa3); partialSM(pA0, pA1, m_reg, mnA, alA, C, thr);
    __syncthreads(); SWAIT(); SWRITE(1, SO);
    RESC(alA); __syncthreads();
  }
  SBAR(); qkt<KS>(pB0, pB1, (bf16_t*)((char*)K_lds + SHM_K), qr, r32, hi);
  finishSM(pA0, pA1, alA, l_reg, pa0, pa1, pa2, pa3); SBAR();
  pv_d0<NOB>(o, vb0, pa0, pa1, pa2, pa3); partialSM(pB0, pB1, m_reg, mnB, alB, C, thr);
  __syncthreads(); RESC(alB);
  finishSM(pB0, pB1, alB, l_reg, pa0, pa1, pa2, pa3); SBAR();
  pv_d0<NOB>(o, vb0 + (int)SHM_V, pa0, pa1, pa2, pa3);
  __builtin_amdgcn_s_setprio(0);
  int tid2 = threadIdx.x; asm volatile("" : "+v"(tid2));
  const int wid2 = tid2 >> 6, r32e = tid2 & 31, hie = (tid2 >> 5) & 1;
  float* li_e = (float*)(lds + 2 * SHM_V + 2 * SHM_K) + wid2 * 64;
  if (hie == 0) li_e[r32e] = l_reg; asm volatile("s_waitcnt lgkmcnt(0)" ::: "memory");
  float rli[16];
#pragma unroll
  for (int r = 0; r < 16; ++r) rli[r] = __builtin_amdgcn_rcpf(li_e[crow(r, hie)]);
  bf16_t* Ow = Ob + (long)(wid2 * QBLK) * LDO;
#pragma unroll
  for (int r = 0; r < 16; ++r) { int orow = crow(r, hie);
#pragma unroll
    for (int d0 = 0; d0 < NOB; ++d0) { const float v = o[d0][r] * rli[r]; Ow[(long)orow * LDO + d0 * 32 + r32e] = (bf16_t)(cvtpk(v, v) & 0xffffu); } }
#undef SLOAD
#undef SWRITE
#undef SWAIT
#undef RESC
  __syncthreads();
}

template <int LDQ, int LDK, int LDO, int NOB, int KS, int GSH>
__device__ __forceinline__ void attn_phase(const bf16_t* Q, const bf16_t* K, const bf16_t* V, bf16_t* O, bool do_ctx, char* lds, float scale) {
  const float C = scale * 1.4426950408889634f, thr = THR / scale;
  const int G = gridDim.x;
  const int nctx = do_ctx ? 32 : 0, total = nctx + 1024;
  for (int uu = blockIdx.x; uu < total + 0; uu += G) {
      long r0, k0; int h, seq;
      if (uu < nctx) { const int b = uu >> 4; h = uu & 15; r0 = (long)b * RB + SEQ; k0 = r0; seq = CTXL; }
      else { const int u = uu - nctx; const int i = u >> 8, c = u & 255, b = i >> 1, qb = c >> 3; h = (i & 1) * 8 + (c & 7); r0 = (long)b * RB + qb * 256; k0 = (long)b * RB; seq = RB; }
      const int kvh = h >> GSH;
      attn_dense_body<LDQ, LDK, LDO, NOB, KS>(Q + r0 * LDQ + h * 128, K + k0 * LDK + kvh * 128, V + k0 * LDK + kvh * 128, O + r0 * LDO + h * (NOB * 32), seq, lds, C, thr);
  }
}
}

template <int PERM_FFN = 0>
__device__ __forceinline__ void transpose_item(const float* __restrict__ W, int K, int N, bf16_t* __restrict__ WT, LAS float* scr, int item, int lane) {
    const int nblk = N / 32, kb = item / nblk, nb = item - kb * nblk, k0 = 64 * kb, n0 = 32 * nb;
#pragma unroll 8
    for (int i = 0; i < 32; ++i) { const int kk = 2 * i + (lane >> 5); scr[kk * 33 + (lane & 31)] = __builtin_nontemporal_load(W + (size_t)(k0 + kk) * N + n0 + (lane & 31)); }
    asm volatile("s_waitcnt lgkmcnt(0)" ::: "memory");
    const int c = lane & 7;
#pragma unroll
    for (int j = 0; j < 4; ++j) { const int n = (lane >> 3) + 8 * j; const LAS float* s = scr + (8 * c) * 33 + n;
        u32x4 o; o.x = pk2(s[0 * 33], s[1 * 33]); o.y = pk2(s[2 * 33], s[3 * 33]); o.z = pk2(s[4 * 33], s[5 * 33]); o.w = pk2(s[6 * 33], s[7 * 33]);
        int nd = n0 + n; if (PERM_FFN == 1) { const int half = n0 / 3072, chn = n0 - half * 3072; nd = (chn >> 7) * 256 + half * 128 + (chn & 127) + n; }
        if (PERM_FFN == 2 && nd < 3072) { const int d = nd & 127, nb = d >> 6, jj = d & 63; nd = (nd & ~127) + 32 * (jj >> 4) + 8 * ((jj >> 2) & 3) + 4 * nb + (jj & 3); }
        *(u32x4*)(WT + (size_t)nd * K + k0 + 8 * c) = o; }
    asm volatile("s_waitcnt lgkmcnt(0)" ::: "memory");
}
template <int PERM_FFN = 0>
__device__ __forceinline__ void transpose_mat(const float* W, int K, int N, bf16_t* WT, LAS float* scr, int gw, int NGW, int lane) {
    const int items = (K / 64) * (N / 32);
    for (int it = gw; it < items; it += NGW) transpose_item<PERM_FFN>(W, K, N, WT, scr, it, lane);
}

struct Params { const float* in[27]; float* out; unsigned char* ws; };
typedef const Params __attribute__((address_space(4)))* KPtr;
__device__ __forceinline__ KPtr kparams() { KPtr k = (KPtr)__builtin_amdgcn_kernarg_segment_ptr(); asm volatile("" : "+s"(k)); return k; }
#define P_IN(i) (kparams()->in[i])
#define P_WS (kparams()->ws)
#define P_OUT (kparams()->out)

__device__ __forceinline__ void convert_mixer_weights(const Params& p, int layer, LAS float* scr, int gw, int NGW, int lane) {
    const int kind = layer % 3, j = layer / 3;
    bf16_t* WM = (bf16_t*)(P_WS + WS_WM);
    if (kind == 0) {
        transpose_mat<2>(P_IN(12) + (size_t)j * 1024 * 4096, 1024, 4096, WM, scr, gw, NGW, lane);
        transpose_mat(P_IN(15) + (size_t)j * 2048 * 1024, 2048, 1024, WM + (size_t)4096 * 1024, scr, gw, NGW, lane);
    } else if (kind == 1) {
        transpose_mat(P_IN(16) + (size_t)j * 1024 * 5120, 1024, 5120, WM, scr, gw, NGW, lane);
        transpose_mat(P_IN(18) + (size_t)j * 1024 * 1024, 1024, 1024, WM + (size_t)5120 * 1024, scr, gw, NGW, lane);
    } else {
        transpose_mat(P_IN(20) + (size_t)j * 1024 * 1056, 1024, 1056, WM, scr, gw, NGW, lane);
        transpose_mat(P_IN(23) + (size_t)j * 768 * 1536, 768, 1536, WM + (size_t)1280 * 1024, scr, gw, NGW, lane);
        transpose_mat(P_IN(24) + (size_t)j * 256 * 2048, 256, 2048, WM + (size_t)1280 * 1024 + (size_t)1536 * 768, scr, gw, NGW, lane);
        transpose_mat(P_IN(25) + (size_t)j * 1024 * 1024, 1024, 1024, WM + (size_t)1280 * 1024 + (size_t)1536 * 768 + (size_t)2048 * 256, scr, gw, NGW, lane);
    }
}
__device__ __forceinline__ void convert_ffn_weights(const Params& p, int layer, LAS float* scr, int gw, int NGW, int lane) {
    bf16_t* WF = (bf16_t*)(P_WS + WS_WF);
    transpose_mat<1>(P_IN(8) + (size_t)layer * 1024 * 6144, 1024, 6144, WF, scr, gw, NGW, lane);
    transpose_mat(P_IN(11) + (size_t)layer * 3072 * 1024, 3072, 1024, WF + (size_t)6144 * 1024, scr, gw, NGW, lane);
}

__device__ __forceinline__ void adaln_phase(const Params& p, LAS float* ldsf, int tid, int l_lo, int l_hi, int blk, int nblk) {
    LAS float* sc = ldsf; LAS float* red = ldsf + 3072;
    const float* c = P_IN(1); const float* cc = P_IN(3); const float* w_ada = P_IN(4); const float* b_ada = P_IN(5);
    float* mod = (float*)(P_WS + WS_MOD);
    __syncthreads();
    for (int i = tid; i < 3072; i += NTHREADS) { const int slot = i >> 10, k = i & 1023; const float v = slot < 2 ? c[slot * 1024 + k] : cc[k]; sc[i] = silu_f(v); }
    __syncthreads();
    for (int item = blk; item < (l_hi - l_lo) * 192; item += nblk) {
        const int lq = item / 192, l = l_lo + lq, n0 = (item - lq * 192) * 32, kp = tid >> 5, nn = tid & 31;
        const float* w = w_ada + ((size_t)l * 1024 + kp * 64) * 6144 + n0 + nn;
        float a0 = 0.f, a1 = 0.f, a2 = 0.f;
#pragma unroll 16
        for (int k = 0; k < 64; ++k) { const float wv = __builtin_nontemporal_load(w + (size_t)k * 6144); a0 += sc[kp * 64 + k] * wv; a1 += sc[1024 + kp * 64 + k] * wv; a2 += sc[2048 + kp * 64 + k] * wv; }
        red[(kp * 3 + 0) * 32 + nn] = a0; red[(kp * 3 + 1) * 32 + nn] = a1; red[(kp * 3 + 2) * 32 + nn] = a2;
        __syncthreads();
        if (tid < 96) { const int slot = tid >> 5; float s = b_ada[l * 6144 + n0 + nn];
            for (int q = 0; q < 16; ++q) s += red[(q * 3 + slot) * 32 + nn];
            mod[((size_t)l * 3 + slot) * 6144 + n0 + nn] = s; }
        __syncthreads();
    }
}
__device__ __forceinline__ void tables_phase(const Params& p, int tid) {
    float* lb = (float*)(P_WS + WS_LB); float* TA = (float*)(P_WS + WS_TA); float* TMt = (float*)(P_WS + WS_TM);
    const float* lbs = P_IN(19);
    if (blockIdx.x == gridDim.x - 1) {
        for (int ch = tid; ch < 1024; ch += NTHREADS) { const float l0 = lbs[ch], l1 = lbs[1024 + ch], l2 = lbs[2048 + ch], l3 = lbs[3072 + ch];
            const float mx = fmaxf(fmaxf(l0, l1), fmaxf(l2, l3)); const float e0 = expf(l0 - mx), e1 = expf(l1 - mx), e2 = expf(l2 - mx), e3 = expf(l3 - mx);
            lb[ch] = e1 / (e0 + e1 + e2 + e3); }
    }
    if (blockIdx.x == gridDim.x - 2 || gridDim.x < 2) {
        for (int i = tid; i < 128 * 32; i += NTHREADS) { const int pos = i >> 5, j = i & 31; const float inv = powf(10000.f, -(float)(2 * j) / 64.f); const float ang = (float)pos * inv;
            TA[2 * i] = cosf(ang); TA[2 * i + 1] = sinf(ang); }
        for (int i = tid; i < 128 * 8; i += NTHREADS) { const int pos = i >> 3, j = i & 7; const float inv = powf(10000.f, -(float)(2 * j) / 16.f); const float ang = (float)pos * inv;
            TMt[2 * i] = cosf(ang); TMt[2 * i + 1] = sinf(ang); }
    }
}

template <bool LATENT_ONLY, bool XNF = false>
__device__ __forceinline__ void prenorm_phase(const float* xlat, const float* xctx, const float* gain, const float* modl, int ci, bf16_t* XN, int gw, int NGW, int lane) {
    for (int r0 = gw; r0 < M; r0 += 2 * NGW) {
        f32x4 v[2][4]; const float* md[2]; bool ok[2]; int rr[2];
#pragma unroll
        for (int u = 0; u < 2; ++u) { const int r = r0 + u * NGW; const int b = r / RB, t = r - b * RB; rr[u] = XNF ? xnf_row(b, t) : r;
            ok[u] = (r < M) && !(LATENT_ONLY && t >= SEQ);
            const float* xr = t < SEQ ? xlat + ((size_t)b * SEQ + t) * D : xctx + ((size_t)b * CTXL + (t - SEQ)) * D;
            md[u] = modl + (t < SEQ ? b : 2) * 6144 + ci * 1024;
            if (ok[u]) {
#pragma unroll
                for (int j = 0; j < 4; ++j) v[u][j] = *(const f32x4*)(xr + j * 256 + lane * 4); } }
#pragma unroll
        for (int u = 0; u < 2; ++u) { if (!ok[u]) continue;
            float s = 0.f;
#pragma unroll
            for (int j = 0; j < 4; ++j) s += (v[u][j].x * v[u][j].x + v[u][j].y * v[u][j].y) + (v[u][j].z * v[u][j].z + v[u][j].w * v[u][j].w);
            const float rs = rsqrtf(wave_sum(s) * (1.f / D) + EPS);
#pragma unroll
            for (int j = 0; j < 4; ++j) { const int c = j * 256 + lane * 4; const f32x4 g = *(const f32x4*)(gain + c), sh = *(const f32x4*)(md[u] + c), sc = *(const f32x4*)(md[u] + 1024 + c);
                const f32x4 y = (v[u][j] * rs) * g * (1.f + sc) + sh; u32x2 w; w.x = pk2(y.x, y.y); w.y = pk2(y.z, y.w);
                *(u32x2*)(XN + (size_t)rr[u] * D + c) = w; } }
    }
}
__device__ __forceinline__ void gqa_qknorm_phase(bf16_t* P, const float* qg, const float* kg, const float* TA, int gw, int NGW, int lane) {
    const int sl = lane >> 4, dd = (lane & 15) * 4;
    for (int r = gw; r < M; r += NGW) {
        const int b = r / RB, t = r - b * RB; const bool lat = t < SEQ; const int ri = t >> 6, ci = t & 63;
        bf16_t* pr = P + (size_t)r * 4096;
        u32x2 la[6], lb2[6];
#pragma unroll
        for (int it = 0; it < 6; ++it) { const bf16_t* pp = pr + (it * 4 + sl) * 128 + dd; la[it] = *(const u32x2*)pp; lb2[it] = *(const u32x2*)(pp + 64); }
#pragma unroll
        for (int it = 0; it < 6; ++it) { const int slot = it * 4 + sl; bf16_t* pp = pr + slot * 128 + dd;
            const u32x2 a = la[it], bb = lb2[it];
            float x1[4] = {bflo(a.x), bfhi(a.x), bflo(a.y), bfhi(a.y)}, x2[4] = {bflo(bb.x), bfhi(bb.x), bflo(bb.y), bfhi(bb.y)};
            float ss = 0.f;
#pragma unroll
            for (int e = 0; e < 4; ++e) ss += x1[e] * x1[e] + x2[e] * x2[e];
            const float rs = rsqrtf(sum16(ss) * (1.f / 128.f) + EPS);
            const float* gn = slot < 16 ? qg : kg; const f32x4 g1 = *(const f32x4*)(gn + dd), g2 = *(const f32x4*)(gn + 64 + dd);
            float o1[4], o2[4];
#pragma unroll
            for (int e = 0; e < 4; ++e) { const float y1 = x1[e] * rs * g1[e], y2 = x2[e] * rs * g2[e];
                if (lat) { const int jj = dd + e; const int pos = jj < 32 ? ri : ci; const f32x2 cs = *(const f32x2*)(TA + (pos * 32 + (jj & 31)) * 2);
                    o1[e] = y1 * cs.x - y2 * cs.y; o2[e] = y1 * cs.y + y2 * cs.x; }
                else { o1[e] = y1; o2[e] = y2; } }
            u32x2 w1, w2; w1.x = pk2(o1[0], o1[1]); w1.y = pk2(o1[2], o1[3]); w2.x = pk2(o2[0], o2[1]); w2.y = pk2(o2[2], o2[3]);
            *(u32x2*)pp = w1; *(u32x2*)(pp + 64) = w2; }
    }
}
__device__ __forceinline__ void mla_norm_phase(const bf16_t* P1, const float* qg, const float* kvg, const float* TMt, bf16_t* CQ, bf16_t* CKV, bf16_t* Qp, bf16_t* Kp, bf16_t* Vp, int gw, int NGW, int lane) {
    for (int r = gw; r < M; r += NGW) {
        const int b = r / RB, t = r - b * RB; const bool lat = t < SEQ; const int ri = t >> 6, ci = t & 63;
        const bf16_t* pr = P1 + (size_t)r * 1280;
        float x[12]; float ss = 0.f;
#pragma unroll
        for (int j = 0; j < 3; ++j) { const u32x2 w = *(const u32x2*)(pr + j * 256 + lane * 4); x[4 * j] = bflo(w.x); x[4 * j + 1] = bfhi(w.x); x[4 * j + 2] = bflo(w.y); x[4 * j + 3] = bfhi(w.y); }
#pragma unroll
        for (int e = 0; e < 12; ++e) ss += x[e] * x[e];
        const float rs = rsqrtf(wave_sum(ss) * (1.f / 768.f) + EPS);
#pragma unroll
        for (int j = 0; j < 3; ++j) { const int c = j * 256 + lane * 4; const f32x4 g = *(const f32x4*)(qg + c);
            u32x2 w; w.x = pk2(x[4 * j] * rs * g.x, x[4 * j + 1] * rs * g.y); w.y = pk2(x[4 * j + 2] * rs * g.z, x[4 * j + 3] * rs * g.w);
            *(u32x2*)(CQ + (size_t)r * 768 + c) = w; }
        { const u32x2 w = *(const u32x2*)(pr + 768 + lane * 4); const float y0 = bflo(w.x), y1 = bfhi(w.x), y2 = bflo(w.y), y3 = bfhi(w.y);
          const float rs2 = rsqrtf(wave_sum(y0 * y0 + y1 * y1 + y2 * y2 + y3 * y3) * (1.f / 256.f) + EPS); const f32x4 g = *(const f32x4*)(kvg + lane * 4);
          u32x2 o; o.x = pk2(y0 * rs2 * g.x, y1 * rs2 * g.y); o.y = pk2(y2 * rs2 * g.z, y3 * rs2 * g.w);
          *(u32x2*)(CKV + (size_t)r * 256 + lane * 4) = o; }
        { const float xr = bf2f(pr[1024 + (lane & 31)]); const float pa = __shfl_xor(xr, 16); float out = xr;
          if (lat) { const int jj = lane & 15; const int pos = jj < 8 ? ri : ci; const f32x2 cs = *(const f32x2*)(TMt + (pos * 8 + (jj & 7)) * 2);
              out = ((lane & 16) == 0) ? (xr * cs.x - pa * cs.y) : (pa * cs.y + xr * cs.x); }
          const bf16_t ob = (bf16_t)(pk2(out, out) & 0xffffu);
          if (lane < 32) {
#pragma unroll
              for (int h = 0; h < 16; ++h) Kp[(size_t)r * 2048 + h * 128 + 64 + lane] = ob; } }
    }
}
template <bool LATENT_ONLY>
__device__ __forceinline__ void convgate_phase(const bf16_t* U, const float* cw, const float* cb, bf16_t* Gb, int gtid, int NT) {
    const int total = (M / 8) * 384;
    for (int idx = gtid; idx < total; idx += NT) {
        const int strip = idx / 384, cgi = idx - strip * 384, c0 = cgi * 8, r0 = strip * 8, t0 = r0 % RB;
        if (LATENT_ONLY && t0 >= SEQ) continue;
        const bool hasprev = (t0 != 0 && t0 != SEQ), hasnext = (t0 + 8 != SEQ && t0 + 8 != RB);
        float wa[3][8], wv[3][8], ba[8], bv[8];
#pragma unroll
        for (int j = 0; j < 3; ++j)
#pragma unroll
            for (int q = 0; q < 2; ++q) { const f32x4 a = *(const f32x4*)(cw + j * 6144 + c0 + 4 * q), v = *(const f32x4*)(cw + j * 6144 + 3072 + c0 + 4 * q);
#pragma unroll
                for (int e = 0; e < 4; ++e) { wa[j][4 * q + e] = a[e]; wv[j][4 * q + e] = v[e]; } }
#pragma unroll
        for (int q = 0; q < 2; ++q) { const f32x4 a = *(const f32x4*)(cb + c0 + 4 * q), v = *(const f32x4*)(cb + 3072 + c0 + 4 * q);
#pragma unroll
            for (int e = 0; e < 4; ++e) { ba[4 * q + e] = a[e]; bv[4 * q + e] = v[e]; } }
        const u32x4 z = {0u, 0u, 0u, 0u};
        u32x4 ra[10], rv[10];
#pragma unroll
        for (int i = 0; i < 10; ++i) { const bool ok = (i == 0) ? hasprev : ((i == 9) ? hasnext : true);
            if (ok) { ra[i] = *(const u32x4*)(U + (size_t)(r0 - 1 + i) * 6144 + c0); rv[i] = *(const u32x4*)(U + (size_t)(r0 - 1 + i) * 6144 + 3072 + c0); } else { ra[i] = z; rv[i] = z; } }
#pragma unroll
        for (int i = 0; i < 8; ++i) {
            const u32x4 pa = ra[i], ca = ra[i + 1], na = ra[i + 2], pv = rv[i], cv = rv[i + 1], nv = rv[i + 2];
            float g[8];
#pragma unroll
            for (int q = 0; q < 4; ++q) {
                const float a_lo = ba[2 * q] + wa[0][2 * q] * bflo(pa[q]) + wa[1][2 * q] * bflo(ca[q]) + wa[2][2 * q] * bflo(na[q]);
                const float a_hi = ba[2 * q + 1] + wa[0][2 * q + 1] * bfhi(pa[q]) + wa[1][2 * q + 1] * bfhi(ca[q]) + wa[2][2 * q + 1] * bfhi(na[q]);
                const float v_lo = bv[2 * q] + wv[0][2 * q] * bflo(pv[q]) + wv[1][2 * q] * bflo(cv[q]) + wv[2][2 * q] * bflo(nv[q]);
                const float v_hi = bv[2 * q + 1] + wv[0][2 * q + 1] * bfhi(pv[q]) + wv[1][2 * q + 1] * bfhi(cv[q]) + wv[2][2 * q + 1] * bfhi(nv[q]);
                g[2 * q] = silu_f(a_lo) * v_lo; g[2 * q + 1] = silu_f(a_hi) * v_hi; }
            u32x4 o; o.x = pk2(g[0], g[1]); o.y = pk2(g[2], g[3]); o.z = pk2(g[4], g[5]); o.w = pk2(g[6], g[7]);
            *(u32x4*)(Gb + (size_t)(r0 + i) * DFF + c0) = o;
        }
    }
}
__device__ __forceinline__ void final_norm_phase(float* xlat, const float* gain, int gw, int NGW, int lane) {
    for (int r = gw; r < 2 * SEQ; r += NGW) {
        float* xr = xlat + (size_t)r * D; f32x4 v[4]; float s = 0.f;
#pragma unroll
        for (int j = 0; j < 4; ++j) { v[j] = *(const f32x4*)(xr + j * 256 + lane * 4); s += (v[j].x * v[j].x + v[j].y * v[j].y) + (v[j].z * v[j].z + v[j].w * v[j].w); }
        const float rs = rsqrtf(wave_sum(s) * (1.f / D) + EPS);
#pragma unroll
        for (int j = 0; j < 4; ++j) { const int c = j * 256 + lane * 4; const f32x4 g = *(const f32x4*)(gain + c); __builtin_nontemporal_store((v[j] * rs) * g, (f32x4*)(xr + c)); }
    }
}

constexpr int NSEG = 8, SEGLEN = 1056, TB = 16, NBATCH = SEGLEN / TB;
__device__ __forceinline__ int hgrn_row(int b, int dir, int tau) {
    if (tau < CTXL) { const int tc = dir ? (CTXL - 1 - tau) : tau; return b * RB + SEQ + tc; }
    const int tt = tau - CTXL; const int t = dir ? (SEQ - 1 - tt) : tt; return b * RB + t;
}
template <bool OUT>
__device__ __forceinline__ void hgrn_scan_item(int item, const bf16_t* __restrict__ P, const float* __restrict__ lbv, float* Lst, float* Dst, bf16_t* Odir, char* lds, int tid) {
    const int seg = item % NSEG, bdh = item / NSEG, h = bdh & 7, dir = (bdh >> 3) & 1, b = bdh >> 4;
    const int wave = tid >> 6, lane = tid & 63;
    float* Fs = (float*)lds; float* Qs = Fs + TB * 128; float* Vs = Qs + TB * 128; float* Ob = Vs + TB * 128;
    f32x2 S[16];
#pragma unroll
    for (int j = 0; j < 16; ++j) S[j] = (f32x2){0.f, 0.f};
    if (OUT) {
        for (int sj = 0; sj < seg; ++sj) { const float* Lj = Lst + (size_t)(bdh * NSEG + sj) * 16384; const float* Dj = Dst + (size_t)(bdh * NSEG + sj) * 128;
#pragma unroll
            for (int j = 0; j < 16; ++j) { const int dk = wave * 16 + j; const float d = Dj[dk]; const f32x2 l2 = *(const f32x2*)(Lj + dk * 128 + 2 * lane); S[j] = S[j] * d + l2; } }
    }
    float Dacc[16];
#pragma unroll
    for (int j = 0; j < 16; ++j) Dacc[j] = 1.f;
    const int ls = tid >> 5, ld0 = (tid & 31) * 4;
    const f32x4 lb4 = *(const f32x4*)(lbv + h * 128 + ld0);
    const int fcol = dir ? 3072 : 2048;
    const float qscale = 0.08838834764831845f;
    u32x2 rf, rq, rv;
    { const int r = hgrn_row(b, dir, seg * SEGLEN + ls); const bf16_t* pp = P + (size_t)r * 5120 + h * 128 + ld0;
      rq = *(const u32x2*)pp; rv = *(const u32x2*)(pp + 1024); rf = *(const u32x2*)(pp + fcol); }
    for (int bi = 0; bi < NBATCH; ++bi) {
        { f32x4 f4, q4, v4;
          f4.x = lb4.x + (1.f - lb4.x) * sigmoid_f(bflo(rf.x)); f4.y = lb4.y + (1.f - lb4.y) * sigmoid_f(bfhi(rf.x));
          f4.z = lb4.z + (1.f - lb4.z) * sigmoid_f(bflo(rf.y)); f4.w = lb4.w + (1.f - lb4.w) * sigmoid_f(bfhi(rf.y));
          q4.x = bflo(rq.x) * qscale; q4.y = bfhi(rq.x) * qscale; q4.z = bflo(rq.y) * qscale; q4.w = bfhi(rq.y) * qscale;
          v4.x = bflo(rv.x); v4.y = bfhi(rv.x); v4.z = bflo(rv.y); v4.w = bfhi(rv.y);
          *(f32x4*)(Fs + ls * 128 + ld0) = f4; *(f32x4*)(Qs + ls * 128 + ld0) = q4; *(f32x4*)(Vs + ls * 128 + ld0) = v4; }
        if (bi + 1 < NBATCH) { const int r = hgrn_row(b, dir, seg * SEGLEN + (bi + 1) * TB + ls); const bf16_t* pp = P + (size_t)r * 5120 + h * 128 + ld0;
            rq = *(const u32x2*)pp; rv = *(const u32x2*)(pp + 1024); rf = *(const u32x2*)(pp + fcol); }
        __syncthreads();
#pragma unroll 2
        for (int s = 0; s < TB; ++s) {
            f32x4 fa[4], qa[4];
#pragma unroll
            for (int k = 0; k < 4; ++k) { fa[k] = *(const f32x4*)(Fs + s * 128 + wave * 16 + 4 * k); if (OUT) qa[k] = *(const f32x4*)(Qs + s * 128 + wave * 16 + 4 * k); }
            const f32x2 v2 = *(const f32x2*)(Vs + s * 128 + 2 * lane);
            f32x2 o0 = (f32x2){0.f, 0.f}, o1 = o0, o2 = o0, o3 = o0;
#pragma unroll
            for (int j = 0; j < 16; j += 4) {
#pragma unroll
                for (int e = 0; e < 4; ++e) { const float f = fa[j >> 2][e]; const f32x2 tdiff = S[j + e] - v2; S[j + e] = tdiff * f + v2; if (!OUT) Dacc[j + e] *= f; }
                if (OUT) { const f32x4 q4 = qa[j >> 2]; o0 += S[j] * q4[0]; o1 += S[j + 1] * q4[1]; o2 += S[j + 2] * q4[2]; o3 += S[j + 3] * q4[3]; }
            }
            if (OUT) *(f32x2*)(Ob + (size_t)(wave * TB + s) * 128 + 2 * lane) = (o0 + o1) + (o2 + o3);
        }
        __syncthreads();
        if (OUT) { f32x4 acc = *(const f32x4*)(Ob + (size_t)ls * 128 + ld0);
#pragma unroll
            for (int w = 1; w < 8; ++w) acc += *(const f32x4*)(Ob + (size_t)(w * TB + ls) * 128 + ld0);
            const int r = hgrn_row(b, dir, seg * SEGLEN + bi * TB + ls); u32x2 w2; w2.x = pk2(acc.x, acc.y); w2.y = pk2(acc.z, acc.w);
            *(u32x2*)(Odir + ((size_t)dir * M + r) * 1024 + h * 128 + ld0) = w2; }
    }
    if (!OUT) { float* Lj = Lst + (size_t)(bdh * NSEG + seg) * 16384; float* Dj = Dst + (size_t)(bdh * NSEG + seg) * 128;
#pragma unroll
        for (int j = 0; j < 16; ++j) { const int dk = wave * 16 + j; *(f32x2*)(Lj + dk * 128 + 2 * lane) = S[j]; if (lane == 0) Dj[dk] = Dacc[j]; } }
    __syncthreads();
}
__device__ __forceinline__ void hgrn_state_item(int item, const bf16_t* __restrict__ P, const float* __restrict__ lbv, float* Lst, float* Dst, char* lds, int tid) {
    const int seg = item % NSEG, bdh = item / NSEG, h = bdh & 7, dir = (bdh >> 3) & 1, b = bdh >> 4;
    const int wave = tid >> 6, lane = tid & 63, r32 = lane & 31, hi = lane >> 5;
    float* LfS = (float*)lds; float* KfS = LfS + 2048;
    bf16_t* Ka = (bf16_t*)(KfS + 2048); bf16_t* Vb = Ka + 2 * 2048;
    const int ls = tid >> 5, ld0 = (tid & 31) * 4;
    const f32x4 lb4 = *(const f32x4*)(lbv + h * 128 + ld0);
    const int fcol = dir ? 3072 : 2048;
    const int mt = wave >> 1, nt0 = (wave & 1) * 2;
    f32x16 acc0 = {}, acc1 = {};
    float carry = 0.f;
    u32x2 rf, rv;
    { const int r = hgrn_row(b, dir, seg * SEGLEN + (NBATCH - 1) * TB + ls); const bf16_t* pp = P + (size_t)r * 5120 + h * 128 + ld0;
      rv = *(const u32x2*)(pp + 1024); rf = *(const u32x2*)(pp + fcol); }
    for (int jb = NBATCH - 1; jb >= 0; --jb) {
        const int buf = jb & 1;
        { f32x4 f4, lf, kf;
          f4.x = lb4.x + (1.f - lb4.x) * sigmoid_f(bflo(rf.x)); f4.y = lb4.y + (1.f - lb4.y) * sigmoid_f(bfhi(rf.x));
          f4.z = lb4.z + (1.f - lb4.z) * sigmoid_f(bflo(rf.y)); f4.w = lb4.w + (1.f - lb4.w) * sigmoid_f(bfhi(rf.y));
#pragma unroll
          for (int e = 0; e < 4; ++e) { lf[e] = __logf(f4[e]); kf[e] = 1.f - f4[e]; }
          *(f32x4*)(LfS + ls * 128 + ld0) = lf; *(f32x4*)(KfS + ls * 128 + ld0) = kf;
          bf16_t* vb = Vb + buf * 2048 + ld0 * 16 + ls;
          vb[0] = (bf16_t)(rv.x & 0xffffu); vb[16] = (bf16_t)(rv.x >> 16); vb[32] = (bf16_t)(rv.y & 0xffffu); vb[48] = (bf16_t)(rv.y >> 16); }
        if (jb > 0) { const int r = hgrn_row(b, dir, seg * SEGLEN + (jb - 1) * TB + ls); const bf16_t* pp = P + (size_t)r * 5120 + h * 128 + ld0;
            rv = *(const u32x2*)(pp + 1024); rf = *(const u32x2*)(pp + fcol); }
        __syncthreads();
        { const int sd = tid & 127, sg = tid >> 7; float lfv[16];
#pragma unroll
          for (int q = 0; q < 16; ++q) lfv[q] = LfS[q * 128 + sd];
          float tot = 0.f, c = carry;
#pragma unroll
          for (int q = 0; q < 16; ++q) { tot += lfv[q]; if (q > 4 * sg + 3) c += lfv[q]; }
          float kh[4];
#pragma unroll
          for (int e = 3; e >= 0; --e) { const int st = 4 * sg + e; kh[e] = KfS[st * 128 + sd] * __expf(c); c += LfS[st * 128 + sd]; }
          carry += tot;
          u32x2 w; w.x = pk2(kh[0], kh[1]); w.y = pk2(kh[2], kh[3]); *(u32x2*)(Ka + buf * 2048 + sd * 16 + 4 * sg) = w; }
        __syncthreads();
        { const bf16x8 a = *(const bf16x8*)(Ka + buf * 2048 + (mt * 32 + r32) * 16 + hi * 8);
          const bf16x8 b0 = *(const bf16x8*)(Vb + buf * 2048 + (nt0 * 32 + r32) * 16 + hi * 8), b1 = *(const bf16x8*)(Vb + buf * 2048 + ((nt0 + 1) * 32 + r32) * 16 + hi * 8);
          acc0 = __builtin_amdgcn_mfma_f32_32x32x16_bf16(a, b0, acc0, 0, 0, 0); acc1 = __builtin_amdgcn_mfma_f32_32x32x16_bf16(a, b1, acc1, 0, 0, 0); }
    }
    float* Lj = Lst + (size_t)item * 16384;
#pragma unroll
    for (int r = 0; r < 16; ++r) { const int row = mt * 32 + (r & 3) + 8 * (r >> 2) + 4 * hi; Lj[row * 128 + nt0 * 32 + r32] = acc0[r]; Lj[row * 128 + (nt0 + 1) * 32 + r32] = acc1[r]; }
    if (tid < 128) Dst[(size_t)item * 128 + tid] = __expf(carry);
    __syncthreads();
}
#define SWZ16(row, colB) ((row) * 256 + ((colB) ^ (((row) & 15) << 4)))
__device__ __forceinline__ void hgrn_out_item(int item, const bf16_t* __restrict__ P, const float* __restrict__ lbv, const float* Lst, const float* Dst, bf16_t* Odir, char* lds, int tid) {
    const int seg = item % NSEG, bdh = item / NSEG, h = bdh & 7, dir = (bdh >> 3) & 1, b = bdh >> 4;
    const int wave = __builtin_amdgcn_readfirstlane(tid >> 6), lane = tid & 63, r32 = lane & 31, hi = lane >> 5;
    float* LfS = (float*)lds; float* KfS = (float*)(lds + 8192); float* QfS = (float*)(lds + 16384); float* Part = (float*)(lds + 24576); float* Ec = (float*)(lds + 26624);
    char* Qt = lds + 28672; char* Kt = lds + 36864; bf16_t* Ka = (bf16_t*)(lds + 45056); bf16_t* Am = (bf16_t*)(lds + 49152); bf16_t* Vb = (bf16_t*)(lds + 50176); char* Sb = lds + 58368;
    const int ls = tid >> 5, ld0 = (tid & 31) * 4;
    const f32x4 lb4 = *(const f32x4*)(lbv + h * 128 + ld0);
    const int fcol = dir ? 3072 : 2048;
    const float qscale = 0.08838834764831845f;
    const int mt = wave >> 1, nt0 = (wave & 1) * 2;
    { const u32x4 z = {0u, 0u, 0u, 0u};
      for (int i = tid; i < 256; i += NTHREADS) { *(u32x4*)(Qt + 4096 + i * 16) = z; *(u32x4*)(Kt + 4096 + i * 16) = z; }
      if (tid < 32) *(u32x4*)((char*)Am + 512 + tid * 16) = z; }
    f32x16 acc0 = {}, acc1 = {};
    for (int sj = 0; sj < seg; ++sj) { const float* Lj = Lst + (size_t)(bdh * NSEG + sj) * 16384; const float* Dj = Dst + (size_t)(bdh * NSEG + sj) * 128;
#pragma unroll
        for (int r = 0; r < 16; ++r) { const int d = mt * 32 + (r & 3) + 8 * (r >> 2) + 4 * hi; const float dd = Dj[d];
            acc0[r] = acc0[r] * dd + Lj[d * 128 + nt0 * 32 + r32]; acc1[r] = acc1[r] * dd + Lj[d * 128 + (nt0 + 1) * 32 + r32]; } }
#define HG_WRITE_SB() do { _Pragma("unroll") for (int q = 0; q < 4; ++q) { const int colB = 2 * (mt * 32 + 8 * q + 4 * hi); \
        u32x2 w0; w0.x = pk2(acc0[4 * q], acc0[4 * q + 1]); w0.y = pk2(acc0[4 * q + 2], acc0[4 * q + 3]); \
        u32x2 w1; w1.x = pk2(acc1[4 * q], acc1[4 * q + 1]); w1.y = pk2(acc1[4 * q + 2], acc1[4 * q + 3]); \
        *(u32x2*)(Sb + SWZ16(nt0 * 32 + r32, colB)) = w0; *(u32x2*)(Sb + SWZ16((nt0 + 1) * 32 + r32, colB)) = w1; } } while (0)
    HG_WRITE_SB();
    u32x2 rf, rq, rv;
#define HG_GLOAD(c) do { const int r_ = hgrn_row(b, dir, seg * SEGLEN + (c) * TB + ls); const bf16_t* pp_ = P + (size_t)r_ * 5120 + h * 128 + ld0; \
        rq = *(const u32x2*)pp_; rv = *(const u32x2*)(pp_ + 1024); rf = *(const u32x2*)(pp_ + fcol); } while (0)
#define HG_STAGE(c) do { f32x4 f4, lf, kf, q4; \
        f4.x = lb4.x + (1.f - lb4.x) * sigmoid_f(bflo(rf.x)); f4.y = lb4.y + (1.f - lb4.y) * sigmoid_f(bfhi(rf.x)); \
        f4.z = lb4.z + (1.f - lb4.z) * sigmoid_f(bflo(rf.y)); f4.w = lb4.w + (1.f - lb4.w) * sigmoid_f(bfhi(rf.y)); \
        _Pragma("unroll") for (int e = 0; e < 4; ++e) { lf[e] = __logf(f4[e]); kf[e] = 1.f - f4[e]; } \
        q4.x = bflo(rq.x) * qscale; q4.y = bfhi(rq.x) * qscale; q4.z = bflo(rq.y) * qscale; q4.w = bfhi(rq.y) * qscale; \
        *(f32x4*)(LfS + ls * 128 + ld0) = lf; *(f32x4*)(KfS + ls * 128 + ld0) = kf; *(f32x4*)(QfS + ls * 128 + ld0) = q4; \
        bf16_t* vb_ = Vb + ((c) & 1) * 2048 + ld0 * 16 + ls; \
        vb_[0] = (bf16_t)(rv.x & 0xffffu); vb_[16] = (bf16_t)(rv.x >> 16); vb_[32] = (bf16_t)(rv.y & 0xffffu); vb_[48] = (bf16_t)(rv.y >> 16); } while (0)
    HG_GLOAD(0); HG_STAGE(0); HG_GLOAD(1);
    __syncthreads();
    const int sd = tid & 127, sg = tid >> 7;
    for (int c = 0; c < NBATCH; ++c) {
        { float lfv[16];
#pragma unroll
          for (int q = 0; q < 16; ++q) lfv[q] = LfS[q * 128 + sd];
          float tot = 0.f, bb = 0.f;
#pragma unroll
          for (int q = 0; q < 16; ++q) { tot += lfv[q]; if (q < 4 * sg) bb += lfv[q]; }
          float kh[4];
#pragma unroll
          for (int e = 0; e < 4; ++e) { const int st = 4 * sg + e; bb += LfS[st * 128 + sd]; const float kk = KfS[st * 128 + sd], qq = QfS[st * 128 + sd];
              const float qt = qq * __expf(bb), kt = kk * __expf(fminf(-bb, 80.f)); kh[e] = kk * __expf(tot - bb);
              *(bf16_t*)(Qt + SWZ16(st, 2 * sd)) = (bf16_t)(pk2(qt, qt) & 0xffffu); *(bf16_t*)(Kt + SWZ16(st, 2 * sd)) = (bf16_t)(pk2(kt, kt) & 0xffffu); }
          u32x2 w; w.x = pk2(kh[0], kh[1]); w.y = pk2(kh[2], kh[3]); *(u32x2*)(Ka + sd * 16 + 4 * sg) = w;
          if (sg == 0) Ec[sd] = __expf(tot); }
        __syncthreads();
        f32x16 oacc = {};
        if (wave < 4) {
#pragma unroll
            for (int kd = 0; kd < 8; ++kd) { const int colB = (16 * kd + 8 * hi) * 2;
                const bf16x8 a = *(const bf16x8*)(Qt + SWZ16(r32, colB)), bq = *(const bf16x8*)(Sb + SWZ16(wave * 32 + r32, colB));
                oacc = __builtin_amdgcn_mfma_f32_32x32x16_bf16(a, bq, oacc, 0, 0, 0); }
        } else if (wave == 4) {
            f32x16 am = {};
#pragma unroll
            for (int kd = 0; kd < 8; ++kd) { const int colB = (16 * kd + 8 * hi) * 2;
                const bf16x8 a = *(const bf16x8*)(Qt + SWZ16(r32, colB)), bq = *(const bf16x8*)(Kt + SWZ16(r32, colB));
                am = __builtin_amdgcn_mfma_f32_32x32x16_bf16(a, bq, am, 0, 0, 0); }
            if (r32 < 16) {
#pragma unroll
                for (int r = 0; r < 8; ++r) { const int t = (r & 3) + 8 * (r >> 2) + 4 * hi; const float v = (r32 <= t) ? am[r] : 0.f; Am[t * 16 + r32] = (bf16_t)(pk2(v, v) & 0xffffu); } }
        }
        {
#pragma unroll
          for (int r = 0; r < 16; ++r) { const float e = Ec[mt * 32 + (r & 3) + 8 * (r >> 2) + 4 * hi]; acc0[r] *= e; acc1[r] *= e; }
          const bf16_t* vbc = Vb + (c & 1) * 2048;
          const bf16x8 a = *(const bf16x8*)(Ka + (mt * 32 + r32) * 16 + hi * 8);
          const bf16x8 b0 = *(const bf16x8*)(vbc + (nt0 * 32 + r32) * 16 + hi * 8), b1 = *(const bf16x8*)(vbc + ((nt0 + 1) * 32 + r32) * 16 + hi * 8);
          acc0 = __builtin_amdgcn_mfma_f32_32x32x16_bf16(a, b0, acc0, 0, 0, 0); acc1 = __builtin_amdgcn_mfma_f32_32x32x16_bf16(a, b1, acc1, 0, 0, 0); }
        __syncthreads();
        if (wave < 4) { const bf16_t* vbc = Vb + (c & 1) * 2048;
            const bf16x8 a = *(const bf16x8*)(Am + r32 * 16 + hi * 8), bq = *(const bf16x8*)(vbc + (wave * 32 + r32) * 16 + hi * 8);
            oacc = __builtin_amdgcn_mfma_f32_32x32x16_bf16(a, bq, oacc, 0, 0, 0);
#pragma unroll
            for (int r = 0; r < 8; ++r) { const int t = (r & 3) + 8 * (r >> 2) + 4 * hi; const int row = hgrn_row(b, dir, seg * SEGLEN + c * TB + t);
                Odir[((size_t)dir * M + row) * 1024 + h * 128 + wave * 32 + r32] = (bf16_t)(pk2(oacc[r], oacc[r]) & 0xffffu); } }
        HG_WRITE_SB();
        if (c + 1 < NBATCH) { HG_STAGE(c + 1); if (c + 2 < NBATCH) HG_GLOAD(c + 2); }
        __syncthreads();
    }
#undef HG_WRITE_SB
#undef HG_GLOAD
#undef HG_STAGE
}
__device__ __forceinline__ void hgrn_readout_phase(const bf16_t* Odir, const bf16_t* P, const float* og, bf16_t* YN, int gw, int NGW, int lane) {
    for (int r = gw; r < M; r += NGW) {
#pragma unroll
        for (int j = 0; j < 2; ++j) { const int col = j * 512 + lane * 8;
            const u32x4 a = *(const u32x4*)(Odir + (size_t)r * 1024 + col), bq = *(const u32x4*)(Odir + ((size_t)M + r) * 1024 + col), gt = *(const u32x4*)(P + (size_t)r * 5120 + 4096 + col);
            float y[8], gg[8]; float ss = 0.f;
#pragma unroll
            for (int q = 0; q < 4; ++q) { y[2 * q] = bflo(a[q]) + bflo(bq[q]); y[2 * q + 1] = bfhi(a[q]) + bfhi(bq[q]); gg[2 * q] = bflo(gt[q]); gg[2 * q + 1] = bfhi(gt[q]); }
#pragma unroll
            for (int e = 0; e < 8; ++e) ss += y[e] * y[e];
            const float rs = rsqrtf(sum16(ss) * (1.f / 128.f) + EPS);
            const f32x4 g0 = *(const f32x4*)(og + (col & 127)), g1 = *(const f32x4*)(og + (col & 127) + 4);
            float o[8];
#pragma unroll
            for (int e = 0; e < 8; ++e) o[e] = y[e] * rs * (e < 4 ? g0[e & 3] : g1[e & 3]) * silu_f(gg[e]);
            u32x4 w; w.x = pk2(o[0], o[1]); w.y = pk2(o[2], o[3]); w.z = pk2(o[4], o[5]); w.w = pk2(o[6], o[7]);
            *(u32x4*)(YN + (size_t)r * 1024 + col) = w; }
    }
}

__device__ __forceinline__ int tid_fresh() { int t = threadIdx.x; asm volatile("" : "+v"(t)); return t; }
#define TID_F (tid_fresh())
#define LANE_F (tid_fresh() & 63)
#define WAVE_F (__builtin_amdgcn_readfirstlane(tid_fresh() >> 6))
#define GW_F ((int)blockIdx.x * NWAVES + WAVE_F)
#define GTID_F ((int)blockIdx.x * NTHREADS + tid_fresh())
#define SCR_F ((LAS float*)(ldsl + WAVE_F * 16384))
#define IDLE_CONVERT(nwg, fn, lay) do { const int cut_ = (nwg) % G; if ((int)blockIdx.x >= cut_) fn(p, lay, SCR_F, ((int)blockIdx.x - cut_) * NWAVES + WAVE_F, (G - cut_) * NWAVES, LANE_F); } while (0)
#define IDLE_ADALN(nwg, lay) do { const int cut_ = (nwg) % G; if ((int)blockIdx.x >= cut_) adaln_phase(p, (LAS float*)ldsl, TID_F, (lay), (lay) + 1, (int)blockIdx.x - cut_, G - cut_); } while (0)
template <int LAYER>
__device__ __forceinline__ void layer_fn(const Params& p, const XcdBarrier& xbar, unsigned char* lds) {
    const int G = gridDim.x, NGW = G * NWAVES, NT = G * NTHREADS;
    LAS unsigned char* ldsl = (LAS unsigned char*)lds;
    unsigned char* ws = P_WS;
    float* mod = (float*)(ws + WS_MOD); const float* lbv = (const float*)(ws + WS_LB); const float* TA = (const float*)(ws + WS_TA); const float* TMt = (const float*)(ws + WS_TM);
    float* XC = (float*)(ws + WS_XC); float* XL = P_OUT;
    bf16_t* WM = (bf16_t*)(ws + WS_WM); bf16_t* WF = (bf16_t*)(ws + WS_WF); bf16_t* XN = (bf16_t*)(ws + WS_XN);
    bf16_t* UB = (bf16_t*)(ws + WS_U); bf16_t* GB = (bf16_t*)(ws + WS_G);
    (void)lbv; (void)TA; (void)TMt; (void)NT;
        constexpr int layer = LAYER; constexpr int kind = layer % 3, lj = layer / 3; constexpr bool last = layer == 3;
        const float* modl = mod + (size_t)layer * 3 * 6144;
        const float* xl_src = layer == 0 ? P_IN(0) : XL; const float* xc_src = layer == 0 ? P_IN(2) : XC;
        PH(2) prenorm_phase<false>(xl_src, xc_src, P_IN(6) + layer * 1024, modl, 0, XN, GW_F, NGW, LANE_F);
        xcd_barrier(xbar);
        if constexpr (kind == 0) {
            PH(3) { pg8::Gemm g{XN, WM, M, 4096, 1024}; pg8::StaticOrder S; S.init(M, 4096, G, (int)blockIdx.x);
              EpiGqaQKV E{UB, P_IN(13) + lj * 128, P_IN(14) + lj * 128, TA, (LAS float*)(ldsl + 132096)};
              pg8::gemm_phase<EpiGqaQKV, pg8::StaticOrder, true, true>(ldsl, g, S, E); }
            IDLE_CONVERT(66 * 16, convert_ffn_weights, layer);
            if constexpr (!last) IDLE_ADALN(66 * 16, layer + 1);
            xcd_barrier(xbar);
            PH(5) att::attn_phase<4096, 4096, 2048, 4, 8, 1>(UB, UB + 2048, UB + 3072, GB, !last, (char*)lds, 0.08838834764831845f);
            xcd_barrier(xbar);
            { if constexpr (!last) ctx_resid_gemm<2048>(GB, WM + (size_t)4096 * 1024, xc_src, XC, modl + 2 * 1024 + 2 * 6144, (char*)lds, TID_F);
              pg8::Gemm g{GB, WM + (size_t)4096 * 1024, M, 1024, 2048}; LatentOrder S; S.init(1024, G, (int)blockIdx.x); EpiResid E{xl_src, xc_src, XL, XC, modl + 2 * 1024};
              pg8::gemm_phase<EpiResid, LatentOrder, true, true>(ldsl, g, S, E); }
            xcd_barrier(xbar);
        } else if constexpr (kind == 1) {
            PH(3) { pg8::Gemm g{XN, WM, M, 5120, 1024}; pg8::StaticOrder S; S.init(M, 5120, G, (int)blockIdx.x); EpiStore E{UB, 5120};
              pg8::gemm_phase<EpiStore, pg8::StaticOrder, true, true>(ldsl, g, S, E); }
            IDLE_CONVERT(66 * 20, convert_ffn_weights, layer);
            IDLE_ADALN(66 * 20, layer + 1);
            xcd_barrier(xbar);
            bf16_t* Odir = GB; float* Lst = (float*)(ws + WS_G + 67 * MiB); float* Dst = (float*)(ws + WS_G + 99 * MiB + 512 * 1024);
            PH(7) for (int it = blockIdx.x; it < 32 * (NSEG - 1); it += G) { const int bdh = it / (NSEG - 1), seg = it - bdh * (NSEG - 1);
                hgrn_state_item(bdh * NSEG + seg, UB, lbv, Lst, Dst, (char*)lds, TID_F); }
            xcd_barrier(xbar);
            PH(8) for (int it = blockIdx.x; it < 32 * NSEG; it += G) { const int k_ = it / 32, seg = k_ < NSEG / 2 ? NSEG - 1 - k_ : k_ - NSEG / 2, bdh = it & 31;
                hgrn_out_item(bdh * NSEG + seg, UB, lbv, Lst, Dst, Odir, (char*)lds, TID_F); }
            xcd_barrier(xbar);
            PH(9) hgrn_readout_phase(Odir, UB, P_IN(17) + lj * 128, XN, GW_F, NGW, LANE_F);
            xcd_barrier(xbar);
            { ctx_resid_gemm<1024>(XN, WM + (size_t)5120 * 1024, xc_src, XC, modl + 2 * 1024 + 2 * 6144, (char*)lds, TID_F);
              pg8::Gemm g{XN, WM + (size_t)5120 * 1024, M, 1024, 1024}; LatentOrder S; S.init(1024, G, (int)blockIdx.x); EpiResid E{xl_src, xc_src, XL, XC, modl + 2 * 1024};
              pg8::gemm_phase<EpiResid, LatentOrder, true, true>(ldsl, g, S, E); }
            xcd_barrier(xbar);
        } else {
            bf16_t* P1 = GB; bf16_t* CQ = GB + (size_t)M * 1280; bf16_t* CKV = CQ + (size_t)M * 768;
            bf16_t* Qp = UB; bf16_t* Kp = UB + (size_t)M * 2048; bf16_t* Vp = Kp + (size_t)M * 2048;
            bf16_t* Wqb = WM + (size_t)1280 * 1024; bf16_t* Wkvb = Wqb + (size_t)1536 * 768; bf16_t* Wo = Wkvb + (size_t)2048 * 256;
            PH(3) { pg8::Gemm g{XN, WM, M, 1280, 1024}; pg8::StaticOrder S; S.init(M, 1280, G, (int)blockIdx.x); EpiStore E{P1, 1280};
              pg8::gemm_phase<EpiStore, pg8::StaticOrder, true, true>(ldsl, g, S, E); }
            IDLE_CONVERT(66 * 5, convert_ffn_weights, layer);
            IDLE_ADALN(66 * 5, layer + 1);
            xcd_barrier(xbar);
            PH(10) mla_norm_phase(P1, P_IN(21) + lj * 768, P_IN(22) + lj * 256, TMt, CQ, CKV, Qp, Kp, Vp, GW_F, NGW, LANE_F);
            xcd_barrier(xbar);
            PH(11) { pg8::Gemm g{CQ, Wqb, M, 1536, 768}; pg8::StaticOrder S; S.init(M, 1536, G, (int)blockIdx.x); EpiMlaQ E{Qp, TMt};
              pg8::gemm_phase<EpiMlaQ, pg8::StaticOrder, true, true>(ldsl, g, S, E); }
            PH(12) { pg8::Gemm g{CKV, Wkvb, M, 2048, 256}; pg8::StaticOrder S; S.init(M, 2048, G, (int)blockIdx.x); EpiMlaKV E{Kp, Vp};
              pg8::gemm_phase<EpiMlaKV, pg8::StaticOrder, false, false>(ldsl, g, S, E); }
            xcd_barrier(xbar);
            PH(13) att::attn_phase<2048, 2048, 1024, 2, 6, 0>(Qp, Kp, Vp, XN, !last, (char*)lds, 0.10206207261596575f);
            xcd_barrier(xbar);
            { ctx_resid_gemm<1024>(XN, Wo, xc_src, XC, modl + 2 * 1024 + 2 * 6144, (char*)lds, TID_F);
              pg8::Gemm g{XN, Wo, M, 1024, 1024}; LatentOrder S; S.init(1024, G, (int)blockIdx.x); EpiResid E{xl_src, xc_src, XL, XC, modl + 2 * 1024};
              pg8::gemm_phase<EpiResid, LatentOrder, true, true>(ldsl, g, S, E); }
            xcd_barrier(xbar);
        }
        PH(2) prenorm_phase<last, true>(XL, XC, P_IN(7) + layer * 1024, modl, 3, XN, GW_F, NGW, LANE_F);
        zero_xnf_guards(XN, TID_F);
        xcd_barrier(xbar);
        PH(3) { pg8::Gemm g{XN, WF, M, 6144, 1024}; FfnOrder<last> S; S.init(G, (int)blockIdx.x);
          EpiConvGate<last> E{GB, P_IN(9) + (size_t)layer * 3 * 6144, P_IN(10) + (size_t)layer * 6144, (LAS float*)(ldsl + 132096)};
          pg8::gemm_phase<EpiConvGate<last>, FfnOrder<last>, true, true>(ldsl, g, S, E); }
        if constexpr (!last) IDLE_CONVERT(70 * 24, convert_mixer_weights, layer + 1);
        xcd_barrier(xbar);
        { if constexpr (!last) ctx_resid_gemm<3072>(GB, WF + (size_t)6144 * 1024, XC, XC, modl + 5 * 1024 + 2 * 6144, (char*)lds, TID_F);
          pg8::Gemm g{GB, WF + (size_t)6144 * 1024, M, 1024, 3072}; LatentOrder S; S.init(1024, G, (int)blockIdx.x); EpiResid E{XL, XC, XL, XC, modl + 5 * 1024};
          pg8::gemm_phase<EpiResid, LatentOrder, true, true>(ldsl, g, S, E); }
        xcd_barrier(xbar);
}

__global__ void __launch_bounds__(NTHREADS, 2) fwd_megakernel(Params p) {
    extern __shared__ __attribute__((aligned(16))) unsigned char lds[];
    cg::grid_group grid = cg::this_grid();
    const int G = gridDim.x, NGW = G * NWAVES;
    LAS unsigned char* ldsl = (LAS unsigned char*)lds;
    volatile LAS unsigned* MISC = (volatile LAS unsigned*)(ldsl + MISC_OFF);
    if (threadIdx.x < 32) MISC[threadIdx.x] = 0u;
    __syncthreads();
    const XcdBarrier xbar = xcd_barrier_post((unsigned*)(P_WS + WS_BAR), MISC + 8);

    PH(0) { adaln_phase(p, (LAS float*)ldsl, TID_F, 0, 1, (int)blockIdx.x, G);
    tables_phase(p, TID_F); }
    __syncthreads();
    PH(1) convert_mixer_weights(p, 0, SCR_F, GW_F, NGW, LANE_F);
    grid.sync();

    layer_fn<0>(p, xbar, lds); layer_fn<1>(p, xbar, lds); layer_fn<2>(p, xbar, lds); layer_fn<3>(p, xbar, lds);
    for (int xs = 0; xs < XSYNC; ++xs) xcd_barrier(xbar);
    final_norm_phase(P_OUT, P_IN(26), GW_F, NGW, LANE_F);
}

extern "C" void kernel_launch(void* const* d_in, const int* in_sizes, int n_in, void* d_out, int out_size, void* d_ws, size_t ws_size, hipStream_t stream) {
    static int grid = 0;
    if (grid == 0) {
        if (n_in != 27 || in_sizes[0] != 2 * SEQ * D || out_size != 2 * SEQ * D || ws_size < WS_END) {
            fprintf(stderr, "kernel_launch: shape/workspace mismatch: n_in %d in0 %d out %d ws %zu (need %zu)\n", n_in, n_in > 0 ? in_sizes[0] : -1, out_size, ws_size, (size_t)WS_END); grid = -1; return; }
        int dev = 0, cus = 0, per_cu = 0;
        if (hipGetDevice(&dev) != hipSuccess || hipDeviceGetAttribute(&cus, hipDeviceAttributeMultiprocessorCount, dev) != hipSuccess) { grid = -1; return; }
        if (hipFuncSetAttribute((const void*)fwd_megakernel, hipFuncAttributeMaxDynamicSharedMemorySize, LDS_BYTES) != hipSuccess) { fprintf(stderr, "kernel_launch: hipFuncSetAttribute failed\n"); grid = -1; return; }
        if (hipOccupancyMaxActiveBlocksPerMultiprocessor(&per_cu, (const void*)fwd_megakernel, NTHREADS, LDS_BYTES) != hipSuccess || per_cu < 1) { fprintf(stderr, "kernel_launch: occupancy query gave %d\n", per_cu); per_cu = 1; }
        (void)hipGetLastError();
        grid = cus * 1;
    }
    if (grid < 0) return;
    if (hipMemsetAsync((char*)d_ws + WS_BAR, 0, WS_BAR_BYTES, stream) != hipSuccess) { fprintf(stderr, "kernel_launch: memset of barrier words failed\n"); return; }
    Params p{};
    for (int i = 0; i < 27; ++i) p.in[i] = (const float*)d_in[i];
    p.out = (float*)d_out; p.ws = (unsigned char*)d_ws;
    void* args[] = {&p};
    hipError_t e = hipLaunchCooperativeKernel((const void*)fwd_megakernel, dim3(grid), dim3(NTHREADS), args, LDS_BYTES, stream);
    if (e != hipSuccess) fprintf(stderr, "kernel_launch: cooperative launch failed: %s (grid %d)\n", hipGetErrorString(e), grid);
}
```
